# Optimizing an MI355X kernel written in HIP

```python
import math
import jax, jax.numpy as jnp
from jax import lax
import numpy as np

D_MODEL = 1024
BATCH = 8
SEQ = 4096
DEPTH = 1

CTX_LEN = 256
GRID_W = 64

RET_HEADS = 4
RET_DK = 128
RET_DV = 128
RET_QK = RET_HEADS * RET_DK
RET_V = RET_HEADS * RET_DV
DIFF_HEADS = 4
DIFF_HD = 64
DIFF_DV = 2 * DIFF_HD
DIFF_QK = DIFF_HEADS * 2 * DIFF_HD
DIFF_V = DIFF_HEADS * DIFF_DV
MIX_WIDTH = RET_V + DIFF_V
IN_COLS = 2 * RET_QK + 2 * RET_V + 2 * DIFF_QK + DIFF_V
D_FF = 2816
CONV_WIDTH = 3
CHUNK = 128
Q_BLOCK = 128
ROPE_BASE = 10000.0
EPS = 1e-6
GN_EPS = 1e-5
N_MOD = 6

kernel_name = "hybrid_retention_diffattn_dit_layer"


def rms_norm(x, g):
    xf = x.astype(jnp.float32)
    y = xf * lax.rsqrt(jnp.mean(xf * xf, axis=-1, keepdims=True) + EPS)
    return (y * g.astype(jnp.float32)).astype(x.dtype)


def grid_rope(rows, head_dim):
    n_freq = head_dim // 4
    inv = ROPE_BASE ** (-jnp.arange(n_freq, dtype=jnp.float32) / n_freq)
    pos = jnp.arange(rows * GRID_W)
    row = (pos // GRID_W).astype(jnp.float32)
    col = (pos % GRID_W).astype(jnp.float32)
    ang = jnp.concatenate([row[:, None] * inv, col[:, None] * inv], axis=-1)
    return jnp.cos(ang), jnp.sin(ang)


def apply_rope(x, cos, sin):
    half = x.shape[-1] // 2
    x1, x2 = x[..., :half], x[..., half:]
    cs = cos[None, :, None, :].astype(x.dtype)
    sn = sin[None, :, None, :].astype(x.dtype)
    return jnp.concatenate([x1 * cs - x2 * sn, x1 * sn + x2 * cs], axis=-1)


def retention_chunked(q, k, v, log_gamma, state0):
    B, H, L, dk = q.shape
    dv = v.shape[-1]
    n = L // CHUNK
    idx = jnp.arange(CHUNK, dtype=jnp.float32)
    rel = idx[:, None] - idx[None, :]
    intra = jnp.where(rel >= 0, jnp.exp(jnp.maximum(rel, 0.0) * log_gamma[:, None, None]), 0.0)
    q_dec = jnp.exp((idx + 1.0) * log_gamma[:, None])
    k_dec = jnp.exp((CHUNK - 1.0 - idx) * log_gamma[:, None])
    c_dec = jnp.exp(CHUNK * log_gamma)

    def to_chunks(t):
        return jnp.moveaxis(t.reshape(B, H, n, CHUNK, t.shape[-1]), 2, 0)

    def step(S, inp):
        qc, kc, vc = inp
        scores = jnp.einsum('bhid,bhjd->bhij', qc, kc) * intra
        o = (jnp.einsum('bhij,bhje->bhie', scores, vc)
             + jnp.einsum('bhid,bhde->bhie', qc * q_dec[..., None], S))
        S = S * c_dec[:, None, None] + jnp.einsum('bhjd,bhje->bhde', kc * k_dec[..., None], vc)
        return S, o

    S, o = lax.scan(step, state0, (to_chunks(q), to_chunks(k), to_chunks(v)))
    o = jnp.moveaxis(o, 0, 2).reshape(B, H, L, dv)
    return o, S


def head_group_norm(o, g):
    B, H, L, dv = o.shape
    mu = jnp.mean(o, axis=-1, keepdims=True)
    var = jnp.mean(jnp.square(o - mu), axis=-1, keepdims=True)
    on = (o - mu) * lax.rsqrt(var + GN_EPS)
    return on.transpose(0, 2, 1, 3).reshape(B, L, H * dv) * g.astype(jnp.float32)


def diff_attention(q, k, v, lam):
    B, H, _, Lq, d = q.shape
    dv = v.shape[-1]
    scale = d ** -0.5

    def attend(qb):
        s = jnp.einsum('bhmqd,bhmkd->bhmqk', qb, k).astype(jnp.float32) * scale
        p = jax.nn.softmax(s, axis=-1)
        a = p[:, :, 0] - lam * p[:, :, 1]
        return jnp.einsum('bhqk,bhke->bhqe', a.astype(v.dtype), v)

    if Lq <= Q_BLOCK:
        return attend(q)
    nb = Lq // Q_BLOCK
    qb = jnp.moveaxis(q.reshape(B, H, 2, nb, Q_BLOCK, d), 3, 0)
    o = lax.map(attend, qb)
    return jnp.moveaxis(o, 0, 2).reshape(B, H, Lq, dv)


def diff_subln(o, g, lambda_init):
    B, H, L, dv = o.shape
    of = o.astype(jnp.float32)
    n = of * lax.rsqrt(jnp.mean(of * of, axis=-1, keepdims=True) + EPS)
    n = n.transpose(0, 2, 1, 3).reshape(B, L, H * dv) * g.astype(jnp.float32) * (1.0 - lambda_init)
    return n.astype(o.dtype)


def split_heads(p, rope_r, rope_d):
    B, L, _ = p.shape
    cuts = np.cumsum([RET_QK, RET_QK, RET_V, RET_V, DIFF_QK, DIFF_QK]).tolist()
    rq, rk, rv, rg, dq, dk, dvv = jnp.split(p, cuts, axis=-1)
    rq = rq.reshape(B, L, RET_HEADS, RET_DK)
    rk = rk.reshape(B, L, RET_HEADS, RET_DK)
    dq = dq.reshape(B, L, 2 * DIFF_HEADS, DIFF_HD)
    dk = dk.reshape(B, L, 2 * DIFF_HEADS, DIFF_HD)
    if rope_r is not None:
        rq = apply_rope(rq, *rope_r)
        rk = apply_rope(rk, *rope_r)
        dq = apply_rope(dq, *rope_d)
        dk = apply_rope(dk, *rope_d)
    rq = rq.transpose(0, 2, 1, 3)
    rk = rk.transpose(0, 2, 1, 3) * (RET_DK ** -0.5)
    rv = rv.reshape(B, L, RET_HEADS, RET_DV).transpose(0, 2, 1, 3)
    dq = dq.reshape(B, L, DIFF_HEADS, 2, DIFF_HD).transpose(0, 2, 3, 1, 4)
    dk = dk.reshape(B, L, DIFF_HEADS, 2, DIFF_HD).transpose(0, 2, 3, 1, 4)
    dvv = dvv.reshape(B, L, DIFF_HEADS, DIFF_DV).transpose(0, 2, 1, 3)
    return (rq, rk, rv, rg), (dq, dk, dvv)


def token_mixers(h_lat, h_ctx, w_in, decay_logit, gn_g, lam_par, subln_g, w_out,
                 lambda_init, rope_r, rope_d, need_ctx):
    dtype = h_lat.dtype
    B = h_lat.shape[0]
    (rq_l, rk_l, rv_l, rg_l), (dq_l, dk_l, dv_l) = split_heads(h_lat @ w_in, rope_r, rope_d)
    (rq_c, rk_c, rv_c, rg_c), (dq_c, dk_c, dv_c) = split_heads(h_ctx @ w_in, None, None)

    log_gamma = jax.nn.log_sigmoid(decay_logit.astype(jnp.float32))
    ret_lat = 0.0
    ret_ctx = 0.0
    for d in range(2):
        def orient(t):
            return jnp.flip(t, axis=2) if d == 1 else t
        qc, kc, vc = [orient(t.astype(jnp.float32)) for t in (rq_c, rk_c, rv_c)]
        ql, kl, vl = [orient(t.astype(jnp.float32)) for t in (rq_l, rk_l, rv_l)]
        s0 = jnp.zeros((B, RET_HEADS, RET_DK, RET_DV), jnp.float32)
        o_c, s_c = retention_chunked(qc, kc, vc, log_gamma[d], s0)
        o_l, _ = retention_chunked(ql, kl, vl, log_gamma[d], s_c)
        ret_lat = ret_lat + head_group_norm(orient(o_l), gn_g[d])
        if need_ctx:
            ret_ctx = ret_ctx + head_group_norm(orient(o_c), gn_g[d])
    y_ret_lat = jax.nn.silu(rg_l) * ret_lat.astype(dtype)

    lp = lam_par.astype(jnp.float32)
    lam = jnp.exp(jnp.sum(lp[0] * lp[1])) - jnp.exp(jnp.sum(lp[2] * lp[3])) + lambda_init
    k_all = jnp.concatenate([dk_c, dk_l], axis=3)
    v_all = jnp.concatenate([dv_c, dv_l], axis=2)
    y_diff_lat = diff_subln(diff_attention(dq_l, k_all, v_all, lam), subln_g, lambda_init)

    out_lat = jnp.concatenate([y_ret_lat, y_diff_lat], axis=-1) @ w_out
    out_ctx = None
    if need_ctx:
        y_ret_ctx = jax.nn.silu(rg_c) * ret_ctx.astype(dtype)
        y_diff_ctx = diff_subln(diff_attention(dq_c, dk_c, dv_c, lam), subln_g, lambda_init)
        out_ctx = jnp.concatenate([y_ret_ctx, y_diff_ctx], axis=-1) @ w_out
    return out_lat, out_ctx


def conv_ffn(h, w_up, conv_w, conv_b, w_down):
    u = h @ w_up
    up = jnp.pad(u, ((0, 0), (1, 1), (0, 0)))
    u = up[:, :-2] * conv_w[0] + up[:, 1:-1] * conv_w[1] + up[:, 2:] * conv_w[2] + conv_b
    a, b = jnp.split(u, 2, axis=-1)
    return (jax.nn.silu(a) * b) @ w_down


def setup_inputs(seed: int = 0) -> dict:
    key = jax.random.key(seed)
    ks = jax.random.split(key, 20)
    f32 = jnp.float32
    D = D_MODEL
    a = 5.0 + jnp.arange(RET_HEADS, dtype=f32)
    base_logit = jnp.log(2.0 ** a - 1.0)
    return {
        "x": jax.random.normal(ks[0], (BATCH, SEQ, D), f32),
        "c": jax.random.normal(ks[1], (BATCH, D), f32),
        "ctx": jax.random.normal(ks[2], (BATCH, CTX_LEN, D), f32),
        "c_ctx": jax.random.normal(ks[3], (D,), f32),
        "w_mod": jax.random.normal(ks[4], (DEPTH, D, N_MOD * D), f32) * (0.5 * D ** -0.5),
        "b_mod": jax.random.normal(ks[5], (DEPTH, N_MOD * D), f32) * 0.02,
        "norm1_g": 1.0 + 0.02 * jax.random.normal(ks[6], (DEPTH, D), f32),
        "w_in": jax.random.normal(ks[7], (DEPTH, D, IN_COLS), f32) * D ** -0.5,
        "ret_decay_logit": base_logit[None, None, :] + 0.1 * jax.random.normal(ks[8], (DEPTH, 2, RET_HEADS), f32),
        "ret_gn_g": 1.0 + 0.02 * jax.random.normal(ks[9], (DEPTH, 2, RET_V), f32),
        "diff_lambda": 0.1 * jax.random.normal(ks[10], (DEPTH, 4, DIFF_HD), f32),
        "diff_subln_g": 1.0 + 0.02 * jax.random.normal(ks[11], (DEPTH, DIFF_V), f32),
        "w_out": jax.random.normal(ks[12], (DEPTH, MIX_WIDTH, D), f32) * MIX_WIDTH ** -0.5,
        "norm2_g": 1.0 + 0.02 * jax.random.normal(ks[13], (DEPTH, D), f32),
        "w_up": jax.random.normal(ks[14], (DEPTH, D, 2 * D_FF), f32) * D ** -0.5,
        "conv_w": jax.random.normal(ks[15], (DEPTH, CONV_WIDTH, 2 * D_FF), f32) * CONV_WIDTH ** -0.5,
        "conv_b": 0.02 * jax.random.normal(ks[16], (DEPTH, 2 * D_FF), f32),
        "w_down": jax.random.normal(ks[17], (DEPTH, D_FF, D), f32) * D_FF ** -0.5,
        "final_g": 1.0 + 0.02 * jax.random.normal(ks[18], (D,), f32),
    }


def reference(x, c, ctx, c_ctx, w_mod, b_mod, norm1_g, w_in, ret_decay_logit, ret_gn_g,
              diff_lambda, diff_subln_g, w_out, norm2_g, w_up, conv_w, conv_b, w_down, final_g):
    L = x.shape[1]
    rows = L // GRID_W
    rope_r = grid_rope(rows, RET_DK)
    rope_d = grid_rope(rows, DIFF_HD)
    sc = jax.nn.silu(c)
    scc = jax.nn.silu(c_ctx)
    for l in range(DEPTH):
        last = l == DEPTH - 1
        lambda_init = 0.8 - 0.6 * math.exp(-0.3 * l)
        m_lat = sc @ w_mod[l] + b_mod[l]
        m_ctx = scc @ w_mod[l] + b_mod[l]
        sh1, sc1, g1, sh2, sc2, g2 = [t[:, None, :] for t in jnp.split(m_lat, N_MOD, axis=-1)]
        csh1, csc1, cg1, csh2, csc2, cg2 = jnp.split(m_ctx, N_MOD, axis=-1)

        h_lat = rms_norm(x, norm1_g[l]) * (1.0 + sc1) + sh1
        h_ctx = rms_norm(ctx, norm1_g[l]) * (1.0 + csc1) + csh1
        y_lat, y_ctx = token_mixers(h_lat, h_ctx, w_in[l], ret_decay_logit[l], ret_gn_g[l],
                                    diff_lambda[l], diff_subln_g[l], w_out[l], lambda_init,
                                    rope_r, rope_d, need_ctx=not last)
        x = x + g1 * y_lat
        h2 = rms_norm(x, norm2_g[l]) * (1.0 + sc2) + sh2
        x = x + g2 * conv_ffn(h2, w_up[l], conv_w[l], conv_b[l], w_down[l])
        if not last:
            ctx = ctx + cg1 * y_ctx
            h2c = rms_norm(ctx, norm2_g[l]) * (1.0 + csc2) + csh2
            ctx = ctx + cg2 * conv_ffn(h2c, w_up[l], conv_w[l], conv_b[l], w_down[l])
    return rms_norm(x, final_g)
```

```cpp
#include <hip/hip_runtime.h>
#include <hip/hip_bf16.h>
#include <cstdio>
#include <cstdint>

typedef unsigned short bf16_t;
typedef float f32x4 __attribute__((ext_vector_type(4)));
typedef unsigned u32x4 __attribute__((ext_vector_type(4)));
typedef unsigned u32x2 __attribute__((ext_vector_type(2)));

constexpr int D = 1024, NB = 8, SEQ = 4096, CTXL = 256, MLAT = NB * SEQ, MCTX = NB * CTXL, MTOT = MLAT + MCTX;
constexpr int INC = 3584, DFF = 2816, DFF2 = 5632, KVL = SEQ + CTXL, NMOD = 6 * D;
constexpr float EPS = 1e-6f, GN_EPS = 1e-5f;
constexpr float LAMBDA_INIT = 0.2f;
constexpr float QSCALE = 0.125f * 1.4426950408889634f;
constexpr float RKSCALE = 0.088388347648318440f;

constexpr size_t MiB = 1u << 20;
constexpr size_t WS_ZERO = 0, ZERO_BYTES = 1 * MiB;
constexpr size_t WS_ROWSS = 0;
constexpr size_t WS_MISC = 512 * 1024;
constexpr size_t WS_MOD = 1 * MiB;
constexpr size_t WS_GAM2 = WS_MOD + 256 * 1024;
constexpr size_t WS_BIAS2 = WS_GAM2 + 64 * 1024;
constexpr size_t WS_ROPE = 2 * MiB;
constexpr size_t WS_COSR = WS_ROPE, WS_SINR = WS_ROPE + 1 * MiB, WS_COSD = WS_ROPE + 2 * MiB, WS_SIND = WS_COSD + 512 * 1024;
constexpr size_t WS_MODP = 5 * MiB;
constexpr size_t WS_WIN = 10 * MiB, WS_WOUT = 18 * MiB, WS_WUP = 20 * MiB, WS_WDOWN = 32 * MiB;
constexpr size_t WS_RA = 40 * MiB;
constexpr size_t WS_XN = WS_RA, WS_TMP = WS_RA, WS_A2 = WS_RA + 1 * MiB;
constexpr size_t WS_RQ = 112 * MiB;
constexpr size_t WS_RKD = WS_RQ + 32 * MiB;
constexpr size_t WS_RV = WS_RKD + 68 * MiB;
constexpr size_t WS_RG = WS_RV + 34 * MiB;
constexpr size_t WS_DQ = WS_RG + 32 * MiB;
constexpr size_t WS_DK = WS_DQ + 32 * MiB;
constexpr size_t WS_DV = WS_DK + 34 * MiB;
constexpr size_t WS_E = WS_DV + 34 * MiB;
constexpr size_t WS_YA = 414 * MiB;
constexpr size_t WS_SCR = 414 * MiB;
constexpr size_t WS_G = 112 * MiB;
constexpr size_t WS_UH = 288 * MiB;
constexpr size_t WS_SCR2 = 112 * MiB;
constexpr size_t WS_SCR3 = 464 * MiB;
constexpr size_t WS_SCR4 = 288 * MiB;
constexpr size_t WS_END = 512 * MiB;
static_assert(WS_E == 378 * MiB, "map");

__device__ __forceinline__ float bf2f(bf16_t v) { return __uint_as_float((unsigned)v << 16); }
__device__ __forceinline__ bf16_t f2bf(float f) { unsigned u = __float_as_uint(f); return (bf16_t)((u + 0x7fffu + ((u >> 16) & 1u)) >> 16); }
__device__ __forceinline__ float siluf(float v) { return v / (1.f + __expf(-v)); }
__device__ __forceinline__ float wave_sum(float v) {
#pragma unroll
    for (int o = 1; o < 64; o <<= 1) v += __shfl_xor(v, o);
    return v;
}
__device__ __forceinline__ float log_sigmoid(float x) { return -log1pf(expf(-x)); }

namespace nv {
__global__ void __launch_bounds__(256) k_mod(const float* __restrict__ c, const float* __restrict__ c_ctx, const float* __restrict__ w_mod, const float* __restrict__ b_mod, float* __restrict__ MOD) {
    const int idx = blockIdx.x * 256 + threadIdx.x;
    if (idx >= 9 * NMOD) return;
    const int r = idx / NMOD, j = idx % NMOD;
    const float* cv = r < 8 ? c + r * D : c_ctx;
    float s = 0.f;
    for (int k = 0; k < D; ++k) s += siluf(cv[k]) * w_mod[(size_t)k * NMOD + j];
    MOD[idx] = s + b_mod[j];
}
__global__ void __launch_bounds__(256) k_small(const float* __restrict__ MOD, const float* __restrict__ norm2_g, const float* __restrict__ w_up, const float* __restrict__ diff_lambda,
                                               float* __restrict__ GAM2, float* __restrict__ BIAS2, float* __restrict__ MISC, float* cosr, float* sinr, float* cosd, float* sind) {
    const int idx = blockIdx.x * 256 + threadIdx.x;
    if (idx < NB * D) { const int b = idx / D, k = idx % D; GAM2[idx] = norm2_g[k] * (1.f + MOD[b * NMOD + 4 * D + k]); }
    if (idx < NB * DFF2) { const int b = idx / DFF2, n = idx % DFF2; float s = 0.f; for (int k = 0; k < D; ++k) s += MOD[b * NMOD + 3 * D + k] * w_up[(size_t)k * DFF2 + n]; BIAS2[idx] = s; }
    if (idx == 0) { float a = 0.f, bb = 0.f; for (int i = 0; i < 64; ++i) { a += diff_lambda[i] * diff_lambda[64 + i]; bb += diff_lambda[128 + i] * diff_lambda[192 + i]; } MISC[0] = expf(a) - expf(bb) + LAMBDA_INIT; }
    if (idx < SEQ * 64) { const int pos = idx >> 6, j = idx & 63; const float inv = powf(10000.f, -(float)(j & 31) / 32.f); const float p = (j < 32) ? (float)(pos >> 6) : (float)(pos & 63); const float a = p * inv; cosr[idx] = cosf(a); sinr[idx] = sinf(a); }
    if (idx < SEQ * 32) { const int pos = idx >> 5, j = idx & 31; const float inv = powf(10000.f, -(float)(j & 15) / 16.f); const float p = (j < 16) ? (float)(pos >> 6) : (float)(pos & 63); const float a = p * inv; cosd[idx] = cosf(a); sind[idx] = sinf(a); }
}
__global__ void __launch_bounds__(256) k_xn(const float* __restrict__ x, const float* __restrict__ ctx, const float* __restrict__ MOD, const float* __restrict__ g, bf16_t* __restrict__ XN) {
    const int lane = threadIdx.x & 63, m = blockIdx.x * 4 + (threadIdx.x >> 6);
    if (m >= MTOT) return;
    const float* xr = m < MLAT ? x + (size_t)m * D : ctx + (size_t)(m - MLAT) * D;
    const int r = m < MLAT ? (m >> 12) : 8;
    const float* sh = MOD + r * NMOD, * sc = sh + D;
    f32x4 v[4]; float s = 0.f;
#pragma unroll
    for (int j = 0; j < 4; ++j) { v[j] = *(const f32x4*)(xr + 4 * lane + 256 * j); s += v[j].x * v[j].x + v[j].y * v[j].y + v[j].z * v[j].z + v[j].w * v[j].w; }
    const float rstd = rsqrtf(wave_sum(s) * (1.f / D) + EPS);
#pragma unroll
    for (int j = 0; j < 4; ++j) { const int k = 4 * lane + 256 * j; const f32x4 gg = *(const f32x4*)(g + k), a = *(const f32x4*)(sc + k), bq = *(const f32x4*)(sh + k);
        const f32x4 h = v[j] * rstd * gg * (1.f + a) + bq;
        u32x2 w; w.x = f2bf(h.x) | ((unsigned)f2bf(h.y) << 16); w.y = f2bf(h.z) | ((unsigned)f2bf(h.w) << 16); *(u32x2*)(XN + (size_t)m * D + k) = w; }
}
__global__ void __launch_bounds__(256) k_gemm(const bf16_t* __restrict__ A, int lda, const float* __restrict__ W, int ldw, int n0, float* __restrict__ C, int ldc, int K) {
    __shared__ float As[16][65], Bs[16][65];
    const int tx = threadIdx.x & 15, ty = threadIdx.x >> 4, m0 = blockIdx.y * 64, nb = blockIdx.x * 64;
    float acc[4][4];
#pragma unroll
    for (int i = 0; i < 4; ++i)
#pragma unroll
        for (int j = 0; j < 4; ++j) acc[i][j] = 0.f;
    for (int k0 = 0; k0 < K; k0 += 16) {
#pragma unroll
        for (int i = 0; i < 4; ++i) { const int e = threadIdx.x + 256 * i, r = e >> 4, cc = e & 15; As[cc][r] = bf2f(A[(size_t)(m0 + r) * lda + k0 + cc]); }
#pragma unroll
        for (int i = 0; i < 4; ++i) { const int e = threadIdx.x + 256 * i, r = e >> 6, cc = e & 63; Bs[r][cc] = W[(size_t)(k0 + r) * ldw + n0 + nb + cc]; }
        __syncthreads();
#pragma unroll
        for (int kk = 0; kk < 16; ++kk) { float a[4], b[4];
#pragma unroll
            for (int i = 0; i < 4; ++i) { a[i] = As[kk][ty * 4 + i]; b[i] = Bs[kk][tx * 4 + i]; }
#pragma unroll
            for (int i = 0; i < 4; ++i)
#pragma unroll
                for (int j = 0; j < 4; ++j) acc[i][j] += a[i] * b[j]; }
        __syncthreads();
    }
#pragma unroll
    for (int i = 0; i < 4; ++i) *(f32x4*)(C + (size_t)(m0 + ty * 4 + i) * ldc + nb + tx * 4) = (f32x4){acc[i][0], acc[i][1], acc[i][2], acc[i][3]};
}
struct P1Out { bf16_t *RQ, *RKD, *RV, *RG, *DQ, *DK, *DV; const float *cosr, *sinr, *cosd, *sind; const float* decay_logit; };
__global__ void __launch_bounds__(256) k_p1post(const float* __restrict__ P, int g, P1Out o) {
    const int m = blockIdx.x, c = threadIdx.x;
    const bool lat = m < MLAT; const int b = lat ? (m >> 12) : ((m - MLAT) >> 8), t = lat ? (m & 4095) : ((m - MLAT) & 255);
    const float* pr = P + (size_t)m * 512;
    if (g == 0 || g == 1) {
        const int h = c >> 6, j = c & 63, c1 = 128 * h + j, c2 = c1 + 64;
        float x1 = pr[c1], x2 = pr[c2], o1 = x1, o2 = x2;
        if (lat) { const float cs = o.cosr[t * 64 + j], sn = o.sinr[t * 64 + j]; o1 = x1 * cs - x2 * sn; o2 = x1 * sn + x2 * cs; }
        if (g == 0) { if (lat) { o.RQ[(size_t)m * 512 + c1] = f2bf(o1); o.RQ[(size_t)m * 512 + c2] = f2bf(o2); } }
        else { const int tc = t & 127;
            for (int d = 0; d < 2; ++d) { const float lg = log_sigmoid(o.decay_logit[d * 4 + h]); const float dec = expf(lg * (float)(d == 0 ? 127 - tc : tc)) * RKSCALE;
                bf16_t* dst = o.RKD + (size_t)d * MTOT * 512 + (size_t)m * 512; dst[c1] = f2bf(o1 * dec); dst[c2] = f2bf(o2 * dec); } }
    } else if (g == 2) { o.RV[(size_t)m * 512 + c] = f2bf(pr[c]); o.RV[(size_t)m * 512 + 256 + c] = f2bf(pr[256 + c]);
    } else if (g == 3) { if (lat) { o.RG[(size_t)m * 512 + c] = f2bf(siluf(pr[c])); o.RG[(size_t)m * 512 + 256 + c] = f2bf(siluf(pr[256 + c])); }
    } else if (g == 4 || g == 5) {
        const int hh = c >> 5, j = c & 31, c1 = 64 * hh + j, c2 = c1 + 32;
        float x1 = pr[c1], x2 = pr[c2], o1 = x1, o2 = x2;
        if (lat) { const float cs = o.cosd[t * 32 + j], sn = o.sind[t * 32 + j]; o1 = x1 * cs - x2 * sn; o2 = x1 * sn + x2 * cs; }
        if (g == 4) { if (lat) { o.DQ[(size_t)m * 512 + c1] = f2bf(o1 * QSCALE); o.DQ[(size_t)m * 512 + c2] = f2bf(o2 * QSCALE); } }
        else { const int pos = lat ? 256 + t : t; bf16_t* dst = o.DK + ((size_t)b * KVL + pos) * 512; dst[c1] = f2bf(o1); dst[c2] = f2bf(o2); }
    } else { const int pos = lat ? 256 + t : t; bf16_t* dst = o.DV + ((size_t)b * KVL + pos) * 512; dst[c] = f2bf(pr[c]); dst[256 + c] = f2bf(pr[256 + c]); }
}
__global__ void __launch_bounds__(128) k_ret(const bf16_t* __restrict__ RQ, const bf16_t* __restrict__ RKD, const bf16_t* __restrict__ RV, const bf16_t* __restrict__ RG,
                                            const float* __restrict__ decay_logit, const float* __restrict__ gn_g, float* __restrict__ TMP, bf16_t* __restrict__ YA) {
    __shared__ float qs[128], ks[128], red[8];
    const int b = blockIdx.x >> 2, h = blockIdx.x & 3, e = threadIdx.x;
    for (int d = 0; d < 2; ++d) {
        const float lg = log_sigmoid(decay_logit[d * 4 + h]), gam = expf(lg);
        const float gg = gn_g[d * 512 + h * 128 + e];
        const bf16_t* KD = RKD + (size_t)d * MTOT * 512;
        float S[128];
#pragma unroll
        for (int i = 0; i < 128; ++i) S[i] = 0.f;
        for (int step = 0; step < KVL; ++step) {
            const bool isctx = step < CTXL; const int tt = isctx ? step : step - CTXL; const int L = isctx ? CTXL : SEQ;
            const int t = d == 0 ? tt : L - 1 - tt; const int m = isctx ? MLAT + b * CTXL + t : b * SEQ + t; const int tc = t & 127;
            const float undo = expf(-lg * (float)(d == 0 ? 127 - tc : tc));
            __syncthreads();
            ks[e] = bf2f(KD[(size_t)m * 512 + h * 128 + e]) * undo;
            qs[e] = isctx ? 0.f : bf2f(RQ[(size_t)m * 512 + h * 128 + e]);
            const float v = bf2f(RV[(size_t)m * 512 + h * 128 + e]);
            __syncthreads();
            float oo = 0.f;
#pragma unroll
            for (int i = 0; i < 128; ++i) { S[i] = gam * S[i] + ks[i] * v; oo += qs[i] * S[i]; }
            if (!isctx) {
                const float s1 = wave_sum(oo), s2 = wave_sum(oo * oo);
                if ((e & 63) == 0) { red[(e >> 6) * 2] = s1; red[(e >> 6) * 2 + 1] = s2; }
                __syncthreads();
                const float mu = (red[0] + red[2]) * (1.f / 128.f); const float var = (red[1] + red[3]) * (1.f / 128.f) - mu * mu;
                const float on = (oo - mu) * rsqrtf(var + GN_EPS) * gg;
                const size_t off = (size_t)m * 512 + h * 128 + e;
                if (d == 0) TMP[off] = on; else YA[(size_t)m * 1024 + h * 128 + e] = f2bf(bf2f(RG[off]) * (TMP[off] + on));
            }
        }
    }
}
__global__ void __launch_bounds__(256) k_attn(const bf16_t* __restrict__ DQ, const bf16_t* __restrict__ DK, const bf16_t* __restrict__ DV, const float* __restrict__ subln_g, const float* __restrict__ MISC, bf16_t* __restrict__ YA) {
    const int tid = threadIdx.x, qi = tid >> 2, mp = (tid >> 1) & 1, hf = tid & 1;
    const int h = blockIdx.y, m = blockIdx.x * 64 + qi, b = m >> 12;
    float q[64];
    const bf16_t* qp = DQ + (size_t)m * 512 + h * 128 + mp * 64;
#pragma unroll
    for (int i = 0; i < 64; ++i) q[i] = bf2f(qp[i]);
    float o[64];
#pragma unroll
    for (int i = 0; i < 64; ++i) o[i] = 0.f;
    float mx = -1e30f, l = 0.f;
    const bf16_t* kb = DK + (size_t)b * KVL * 512 + h * 128 + mp * 64;
    const bf16_t* vb = DV + (size_t)b * KVL * 512 + h * 128 + hf * 64;
    for (int j = 0; j < KVL; ++j) {
        const bf16_t* kr = kb + (size_t)j * 512; const bf16_t* vr = vb + (size_t)j * 512;
        float s = 0.f;
#pragma unroll
        for (int i = 0; i < 64; i += 8) { const u32x4 w = *(const u32x4*)(kr + i);
            s += q[i] * __uint_as_float(w.x << 16) + q[i + 1] * __uint_as_float(w.x & 0xffff0000u) + q[i + 2] * __uint_as_float(w.y << 16) + q[i + 3] * __uint_as_float(w.y & 0xffff0000u)
               + q[i + 4] * __uint_as_float(w.z << 16) + q[i + 5] * __uint_as_float(w.z & 0xffff0000u) + q[i + 6] * __uint_as_float(w.w << 16) + q[i + 7] * __uint_as_float(w.w & 0xffff0000u); }
        if (s > mx) { const float a = exp2f(mx - s); l *= a;
#pragma unroll
            for (int i = 0; i < 64; ++i) o[i] *= a;
            mx = s; }
        const float p = exp2f(s - mx); l += p;
#pragma unroll
        for (int i = 0; i < 64; i += 8) { const u32x4 w = *(const u32x4*)(vr + i);
            o[i] += p * __uint_as_float(w.x << 16); o[i + 1] += p * __uint_as_float(w.x & 0xffff0000u); o[i + 2] += p * __uint_as_float(w.y << 16); o[i + 3] += p * __uint_as_float(w.y & 0xffff0000u);
            o[i + 4] += p * __uint_as_float(w.z << 16); o[i + 5] += p * __uint_as_float(w.z & 0xffff0000u); o[i + 6] += p * __uint_as_float(w.w << 16); o[i + 7] += p * __uint_as_float(w.w & 0xffff0000u); }
    }
    const float lam = MISC[0], rl = 1.f / l; float ss = 0.f;
#pragma unroll
    for (int i = 0; i < 64; ++i) { const float mine = o[i] * rl, other = __shfl_xor(mine, 2); const float dd = mp == 0 ? mine - lam * other : other - lam * mine; o[i] = dd; ss += dd * dd; }
    ss += __shfl_xor(ss, 1);
    const float rs = rsqrtf(ss * (1.f / 128.f) + EPS) * (1.f - LAMBDA_INIT);
    if (mp == 0) { bf16_t* yo = YA + (size_t)m * 1024 + 512 + h * 128 + hf * 64; const float* gg = subln_g + h * 128 + hf * 64;
#pragma unroll
        for (int i = 0; i < 64; ++i) yo[i] = f2bf(o[i] * rs * gg[i]); }
}
__global__ void __launch_bounds__(256) k_post_wout(const float* __restrict__ ACC, const float* __restrict__ x, const float* __restrict__ MOD, const float* __restrict__ GAM2, float* __restrict__ OUT, bf16_t* __restrict__ A2, float* __restrict__ rowss) {
    const int lane = threadIdx.x & 63, m = blockIdx.x * 4 + (threadIdx.x >> 6), b = m >> 12; float s = 0.f;
#pragma unroll
    for (int j = 0; j < 4; ++j) { const int k = 4 * lane + 256 * j; const f32x4 a = *(const f32x4*)(ACC + (size_t)m * D + k), xv = *(const f32x4*)(x + (size_t)m * D + k), g1 = *(const f32x4*)(MOD + b * NMOD + 2 * D + k), g2 = *(const f32x4*)(GAM2 + b * D + k);
        const f32x4 x1 = xv + g1 * a; *(f32x4*)(OUT + (size_t)m * D + k) = x1; s += x1.x * x1.x + x1.y * x1.y + x1.z * x1.z + x1.w * x1.w; const f32x4 hq = x1 * g2;
        u32x2 w; w.x = f2bf(hq.x) | ((unsigned)f2bf(hq.y) << 16); w.y = f2bf(hq.z) | ((unsigned)f2bf(hq.w) << 16); *(u32x2*)(A2 + (size_t)m * D + k) = w; }
    s = wave_sum(s); if (lane == 0) rowss[m] = s;
}
__global__ void __launch_bounds__(256) k_post_up(const float* __restrict__ ACC, int n0, int row0, const float* __restrict__ rowss, const float* __restrict__ BIAS2, bf16_t* __restrict__ UH) {
    const int r = blockIdx.x, m = row0 + r, b = m >> 12; const float rstd = rsqrtf(rowss[m] * (1.f / D) + EPS);
    for (int c = threadIdx.x; c < 512; c += 256) UH[(size_t)r * DFF2 + n0 + c] = f2bf(rstd * ACC[(size_t)r * 512 + c] + BIAS2[b * DFF2 + n0 + c]);
}
__global__ void __launch_bounds__(256) k_conv(const bf16_t* __restrict__ UH, int row0, const float* __restrict__ conv_w, const float* __restrict__ conv_b, bf16_t* __restrict__ G) {
    const int r = blockIdx.x, m = row0 + r, t = m & 4095;
    for (int j = threadIdx.x; j < DFF; j += 256) {
        float ca = conv_b[j], cb = conv_b[DFF + j];
        if (t > 0)    { ca += conv_w[j] * bf2f(UH[(size_t)(r - 1) * DFF2 + j]);            cb += conv_w[DFF + j] * bf2f(UH[(size_t)(r - 1) * DFF2 + DFF + j]); }
                      { ca += conv_w[DFF2 + j] * bf2f(UH[(size_t)r * DFF2 + j]);           cb += conv_w[DFF2 + DFF + j] * bf2f(UH[(size_t)r * DFF2 + DFF + j]); }
        if (t < 4095) { ca += conv_w[2 * DFF2 + j] * bf2f(UH[(size_t)(r + 1) * DFF2 + j]); cb += conv_w[2 * DFF2 + DFF + j] * bf2f(UH[(size_t)(r + 1) * DFF2 + DFF + j]); }
        G[(size_t)m * DFF + j] = f2bf(siluf(ca) * cb);
    }
}
__global__ void __launch_bounds__(256) k_post_down(const float* __restrict__ ACC, const float* __restrict__ MOD, const float* __restrict__ final_g, float* __restrict__ OUT) {
    const int lane = threadIdx.x & 63, m = blockIdx.x * 4 + (threadIdx.x >> 6), b = m >> 12; float s = 0.f; f32x4 v[4];
#pragma unroll
    for (int j = 0; j < 4; ++j) { const int k = 4 * lane + 256 * j; const f32x4 a = *(const f32x4*)(ACC + (size_t)m * D + k), x1 = *(const f32x4*)(OUT + (size_t)m * D + k), g2 = *(const f32x4*)(MOD + b * NMOD + 5 * D + k);
        v[j] = x1 + g2 * a; s += v[j].x * v[j].x + v[j].y * v[j].y + v[j].z * v[j].z + v[j].w * v[j].w; }
    const float rstd = rsqrtf(wave_sum(s) * (1.f / D) + EPS);
#pragma unroll
    for (int j = 0; j < 4; ++j) { const int k = 4 * lane + 256 * j; *(f32x4*)(OUT + (size_t)m * D + k) = v[j] * rstd * *(const f32x4*)(final_g + k); }
}
}
namespace pg8 {
#define PG8_LAS __attribute__((address_space(3)))
typedef unsigned short bf16_t;
typedef short bf16x8 __attribute__((ext_vector_type(8)));
typedef float f32x4 __attribute__((ext_vector_type(4)));
typedef unsigned u32x4 __attribute__((ext_vector_type(4)));
constexpr int BM = 256, BK = 64, HALF = 128, HTB = HALF * BK * 2  , STAGE_BYTES = 8 * HTB, NXCD = 8, WGM = 8;

__host__ __device__ __forceinline__ int lds_byte(int r, int c) { const int st = (r >> 4) * 2 + (c >> 5), rr = r & 15, cc = c & 31, ob = rr * 64 + cc * 2; return st * 1024 + (ob ^ (((ob >> 9) & 1) << 5)); }
__host__ __device__ __forceinline__ void stage_rc(int b, int& R, int& C) { const int st = b / 1024, sb = b % 1024, swz = sb ^ (((sb >> 9) & 1) << 5); R = (st >> 1) * 16 + swz / 64; C = (st & 1) * 32 + (swz % 64) / 2; }
__host__ __device__ __forceinline__ int perm32(int rho) { const int n = rho >> 4, i = rho & 15; return 8 * (i >> 2) + 4 * n + (i & 3); }

struct Unit { int pm, pn; };
struct Gemm { const bf16_t* A; const bf16_t* Bt; int M, N, K; };

struct StaticOrder {
    int nM, nN, nwg, G, c;
    __host__ __device__ void init(int M, int N, int G_, int c_) { nM = M / BM; nN = N / BM; nwg = nM * nN; G = G_; c = c_; }
    __host__ __device__ bool next(int i, Unit& u) const {
        const long L = (long)i * G + c; if (L >= nwg) return false;
        int wgid = (int)L; { const int q = nwg / NXCD, r = nwg % NXCD, xcd = wgid % NXCD, off = wgid / NXCD; wgid = (xcd < r ? xcd * (q + 1) : r * (q + 1) + (xcd - r) * q) + off; }
        const int nig = WGM * nN, gid = wgid / nig, fm = gid * WGM, gsz = (nM - fm) < WGM ? (nM - fm) : WGM;
        u.pm = fm + ((wgid % nig) % gsz); u.pn = (wgid % nig) / gsz; return true;
    }
    __device__ __forceinline__ void a_ready(const Unit&) const {}
    __device__ __forceinline__ void done(const Unit&) const {}
};

__device__ __forceinline__ unsigned cvt_pk_bf16(float lo, float hi) { unsigned r; asm volatile("v_cvt_pk_bf16_f32 %0, %1, %2" : "=v"(r) : "v"(lo), "v"(hi)); return r; }
template <class Epi, class Sched, bool ALIGN_EPI = false, bool SP2 = false>
__device__ __forceinline__ void gemm_phase(PG8_LAS unsigned char* lds, const Gemm g, const Sched& S, const Epi& E) {
    const int tid = threadIdx.x, wid = __builtin_amdgcn_readfirstlane(tid >> 6), lane = tid & 63, wr = wid >> 2, wc = wid & 3, fr = lane & 15, fq = lane >> 4;
    const int K = g.K, nt = K / BK;
    unsigned voffA[2], voffB[2];
#pragma unroll
    for (int i = 0; i < 2; ++i) { int R, C; stage_rc(tid * 16 + i * 8192, R, C); const int Rb = Epi::PERM ? ((R & ~31) + perm32(R & 31)) : R;
        voffA[i] = (unsigned)(R * K + C) * 2u; voffB[i] = (unsigned)(Rb * K + C) * 2u; }
    const size_t kstep = (size_t)(BK * 2);
    const size_t hstep = (size_t)HALF * K * 2;
    const size_t tstep = 2 * hstep;
    const unsigned ldsw = (unsigned)wid * 1024u;
    const int aoff = lds_byte(wr * 64 + fr, fq * 8), boff = lds_byte(wc * 32 + fr, fq * 8);
#define PG8_SA(b, h) (((b) * 2 + (h)) * HTB)
#define PG8_SB(b, h) ((4 + (b) * 2 + (h)) * HTB)
#define PG8_STAGE(bufoff, gbase, voff) do { _Pragma("unroll") for (int _i = 0; _i < 2; ++_i) \
        __builtin_amdgcn_global_load_lds((const unsigned*)((const char*)(gbase) + (voff)[_i]), (PG8_LAS unsigned*)(lds + (bufoff) + ldsw + _i * 8192), 16, 0, 0); } while (0)
#define PG8_LDA(dst, b, h) do { _Pragma("unroll") for (int m = 0; m < 4; ++m) _Pragma("unroll") for (int k = 0; k < 2; ++k) dst[m][k] = *(const PG8_LAS bf16x8*)(lds + PG8_SA(b, h) + aoff + m * 2048 + k * 1024); } while (0)
#define PG8_LDB(dst, b, h) do { _Pragma("unroll") for (int n = 0; n < 2; ++n) _Pragma("unroll") for (int k = 0; k < 2; ++k) dst[n][k] = *(const PG8_LAS bf16x8*)(lds + PG8_SB(b, h) + boff + n * 2048 + k * 1024); } while (0)
#define PG8_MMA(ai, bj, At, Bt) do { __builtin_amdgcn_s_setprio(1); _Pragma("unroll") for (int m = 0; m < 4; ++m) _Pragma("unroll") for (int n = 0; n < 2; ++n) _Pragma("unroll") for (int k = 0; k < 2; ++k) \
        acc[ai][bj][m][n] = __builtin_amdgcn_mfma_f32_16x16x32_bf16(Bt[n][k], At[m][k], acc[ai][bj][m][n], 0, 0, 0); __builtin_amdgcn_s_setprio(0); } while (0)
#define PG8_WAIT_V(n) asm volatile("s_waitcnt vmcnt(" #n ")" ::: "memory")
#define PG8_WAIT_L(n) asm volatile("s_waitcnt lgkmcnt(" #n ")" ::: "memory")
#define PG8_BAR __builtin_amdgcn_s_barrier()
#define PG8_SCHED __builtin_amdgcn_sched_barrier(0)
    Unit cur, nxt; int ui = 0;
    if (!S.next(0, cur)) return;
    f32x4 acc[2][2][4][2];
#pragma unroll
    for (int a = 0; a < 2; ++a)
#pragma unroll
        for (int b = 0; b < 2; ++b)
#pragma unroll
            for (int m = 0; m < 4; ++m)
#pragma unroll
                for (int n = 0; n < 2; ++n) acc[a][b][m][n] = (f32x4){0.f, 0.f, 0.f, 0.f};
    bf16x8 At[4][2], B0[2][2], B1[2][2];
    const char* cA = (const char*)g.A + (size_t)cur.pm * tstep; const char* cB = (const char*)g.Bt + (size_t)cur.pn * tstep;
    S.a_ready(cur);
    if constexpr (SP2) {
        PG8_STAGE(PG8_SB(0, 0), cB, voffB); PG8_STAGE(PG8_SB(0, 1), cB + hstep, voffB); PG8_STAGE(PG8_SA(0, 0), cA, voffA); PG8_STAGE(PG8_SA(0, 1), cA + hstep, voffA);
        if (wr == 1) PG8_BAR;
        PG8_WAIT_V(2); PG8_BAR;
        PG8_STAGE(PG8_SB(1, 0), cB + kstep, voffB); PG8_STAGE(PG8_SA(1, 0), cA + kstep, voffA); PG8_STAGE(PG8_SB(1, 1), cB + hstep + kstep, voffB);
        PG8_WAIT_V(6); PG8_BAR;
    } else {
        PG8_STAGE(PG8_SB(0, 0), cB, voffB); PG8_STAGE(PG8_SA(0, 0), cA, voffA); PG8_STAGE(PG8_SB(0, 1), cB + hstep, voffB); PG8_STAGE(PG8_SA(0, 1), cA + hstep, voffA);
        if (wr == 1) PG8_BAR;
        PG8_WAIT_V(4); PG8_BAR;
        PG8_STAGE(PG8_SB(1, 0), cB + kstep, voffB); PG8_STAGE(PG8_SA(1, 0), cA + kstep, voffA); PG8_STAGE(PG8_SB(1, 1), cB + hstep + kstep, voffB);
        PG8_WAIT_V(6); PG8_BAR;
    }
    for (;;) {
        const bool has_next = S.next(ui + 1, nxt);
        const char* nA = has_next ? (const char*)g.A + (size_t)nxt.pm * tstep : cA; const char* nB = has_next ? (const char*)g.Bt + (size_t)nxt.pn * tstep : cB;
        for (int t = 0; t < nt; t += 2) {
            const bool last = (t == nt - 2);
            const char* a1 = cA + (size_t)(t + 1) * kstep;
            const char* a2 = last ? nA : cA + (size_t)(t + 2) * kstep; const char* b2 = last ? nB : cB + (size_t)(t + 2) * kstep;
            const char* a3 = a2 + kstep; const char* b3 = b2 + kstep;
            if (last && has_next) S.a_ready(nxt);
            if constexpr (SP2) {
            PG8_LDB(B0, 0, 0); PG8_LDB(B1, 0, 1); PG8_SCHED; PG8_LDA(At, 0, 0); PG8_STAGE(PG8_SA(1, 1), a1 + hstep, voffA);
            PG8_WAIT_V(8); PG8_WAIT_L(0); PG8_BAR; PG8_MMA(0, 0, At, B0); PG8_MMA(0, 1, At, B1); PG8_BAR; PG8_SCHED;
            PG8_LDA(At, 0, 1); PG8_STAGE(PG8_SB(0, 0), b2, voffB); PG8_STAGE(PG8_SB(0, 1), b2 + hstep, voffB); PG8_STAGE(PG8_SA(0, 0), a2, voffA);
            PG8_WAIT_V(8); PG8_WAIT_L(0); PG8_BAR; PG8_MMA(1, 0, At, B0); PG8_MMA(1, 1, At, B1); PG8_BAR; PG8_SCHED;
            PG8_LDB(B0, 1, 0); PG8_LDB(B1, 1, 1); PG8_SCHED; PG8_LDA(At, 1, 0); PG8_STAGE(PG8_SA(0, 1), a2 + hstep, voffA);
            PG8_WAIT_V(8); PG8_WAIT_L(0); PG8_BAR; PG8_MMA(0, 0, At, B0); PG8_MMA(0, 1, At, B1); PG8_BAR; PG8_SCHED;
            PG8_LDA(At, 1, 1); PG8_STAGE(PG8_SB(1, 0), b3, voffB); PG8_STAGE(PG8_SB(1, 1), b3 + hstep, voffB); PG8_STAGE(PG8_SA(1, 0), a3, voffA);
            PG8_WAIT_V(8); PG8_WAIT_L(0); PG8_BAR; PG8_MMA(1, 0, At, B0); PG8_MMA(1, 1, At, B1); PG8_BAR; PG8_SCHED;
            } else {
            PG8_LDB(B0, 0, 0); PG8_SCHED; PG8_LDA(At, 0, 0); PG8_STAGE(PG8_SA(1, 1), a1 + hstep, voffA);
            PG8_WAIT_L(8); PG8_BAR; PG8_WAIT_L(0); PG8_MMA(0, 0, At, B0); PG8_BAR; PG8_SCHED;
            PG8_LDB(B1, 0, 1); PG8_STAGE(PG8_SB(0, 0), b2, voffB);
            PG8_BAR; PG8_WAIT_L(0); PG8_MMA(0, 1, At, B1); PG8_BAR;
            PG8_LDA(At, 0, 1); PG8_STAGE(PG8_SA(0, 0), a2, voffA);
            PG8_BAR; PG8_WAIT_L(0); PG8_MMA(1, 0, At, B0); PG8_BAR; PG8_SCHED;
            PG8_STAGE(PG8_SB(0, 1), b2 + hstep, voffB);
            PG8_WAIT_V(6); PG8_BAR; PG8_MMA(1, 1, At, B1); PG8_BAR;
            PG8_LDB(B0, 1, 0); PG8_SCHED; PG8_LDA(At, 1, 0); PG8_STAGE(PG8_SA(0, 1), a2 + hstep, voffA);
            PG8_WAIT_L(8); PG8_BAR; PG8_WAIT_L(0); PG8_MMA(0, 0, At, B0); PG8_BAR; PG8_SCHED;
            PG8_LDB(B1, 1, 1); PG8_STAGE(PG8_SB(1, 0), b3, voffB);
            PG8_BAR; PG8_WAIT_L(0); PG8_MMA(0, 1, At, B1); PG8_BAR;
            PG8_LDA(At, 1, 1); PG8_STAGE(PG8_SA(1, 0), a3, voffA);
            PG8_BAR; PG8_WAIT_L(0); PG8_MMA(1, 0, At, B0); PG8_BAR; PG8_SCHED;
            PG8_STAGE(PG8_SB(1, 1), b3 + hstep, voffB);
            PG8_WAIT_V(6); PG8_BAR; PG8_MMA(1, 1, At, B1); PG8_BAR;
            }
        }
        if constexpr (ALIGN_EPI) { if (wr == 0) PG8_BAR; }
        if constexpr (!Epi::AFTER_DRAIN) { E(acc, cur, wr, wc, fr, fq); S.done(cur); }
        if (!has_next) break;
#pragma unroll
        for (int a = 0; a < 2; ++a)
#pragma unroll
            for (int b = 0; b < 2; ++b)
#pragma unroll
                for (int m = 0; m < 4; ++m)
#pragma unroll
                    for (int n = 0; n < 2; ++n) acc[a][b][m][n] = (f32x4){0.f, 0.f, 0.f, 0.f};
        cur = nxt; cA = nA; cB = nB; ++ui;
        if constexpr (ALIGN_EPI) { if (wr == 1) PG8_BAR; }
    }
    PG8_WAIT_V(0);
    if constexpr (!ALIGN_EPI) { if (wr == 0) PG8_BAR; }
    PG8_BAR;
    if constexpr (Epi::AFTER_DRAIN) { E.fused(acc, cur, wr, wc, fr, fq, lds, wid, lane); S.done(cur); }
#undef PG8_SA
#undef PG8_SB
#undef PG8_STAGE
#undef PG8_LDA
#undef PG8_LDB
#undef PG8_MMA
#undef PG8_WAIT_V
#undef PG8_WAIT_L
#undef PG8_BAR
#undef PG8_SCHED
}
}
#include <hip/hip_cooperative_groups.h>
namespace cg = cooperative_groups;
namespace mk {
#define LAS __attribute__((address_space(3)))
using pg8::Unit; using pg8::Gemm; using pg8::StaticOrder; using pg8::cvt_pk_bf16;
constexpr int NTHR = 512, NWAVES = 8, LDS_BYTES = 147456;
constexpr float LOG2E = 1.4426950408889634f;

struct Args { const float* in[19]; float* out; unsigned char* ws; int ph_lo, ph_hi; };

__device__ __forceinline__ void store8(bf16_t* p, f32x4 a, f32x4 b) {
    u32x4 w; w.x = cvt_pk_bf16(a[0], a[1]); w.y = cvt_pk_bf16(a[2], a[3]); w.z = cvt_pk_bf16(b[0], b[1]); w.w = cvt_pk_bf16(b[2], b[3]); *(u32x4*)p = w;
}
__device__ __forceinline__ f32x4 silu4(f32x4 v) { f32x4 r; r.x = siluf(v.x); r.y = siluf(v.y); r.z = siluf(v.z); r.w = siluf(v.w); return r; }

__device__ __forceinline__ int colmap_in(int np) {
    const int pn = np >> 8, tl = np & 255, bj = tl >> 7, u = tl & 127, g = pn >> 1, sub = pn & 1;
    if (g == 0 || g == 1) return 512 * g + 256 * sub + 128 * (u >> 6) + 64 * bj + (u & 63);
    if (g == 4 || g == 5) return 512 * g + 256 * sub + 64 * (u >> 5) + 32 * bj + (u & 31);
    return np;
}
__device__ __forceinline__ int colmap_up(int np) { const int pn = np >> 8, tl = np & 255, bj = tl >> 7, u = tl & 127; return bj * DFF + 128 * pn + u; }

__device__ __forceinline__ unsigned pk2(float lo, float hi) { return (unsigned)f2bf(lo) | ((unsigned)f2bf(hi) << 16); }
__device__ __forceinline__ void transpose_item(const float* __restrict__ W, int K, int N, bf16_t* __restrict__ WT, int k0, int nrow0, int src0, LAS float* scr, int lane) {
#pragma unroll 8
    for (int i = 0; i < 32; ++i) { const int kk = 2 * i + (lane >> 5); scr[kk * 33 + (lane & 31)] = W[(size_t)(k0 + kk) * N + src0 + (lane & 31)]; }
    asm volatile("s_waitcnt lgkmcnt(0)" ::: "memory");
    const int c = lane & 7;
#pragma unroll
    for (int j = 0; j < 4; ++j) { const int n = (lane >> 3) + 8 * j; const LAS float* s = scr + (8 * c) * 33 + n;
        u32x4 o; o.x = pk2(s[0 * 33], s[1 * 33]); o.y = pk2(s[2 * 33], s[3 * 33]); o.z = pk2(s[4 * 33], s[5 * 33]); o.w = pk2(s[6 * 33], s[7 * 33]);
        *(u32x4*)(WT + (size_t)(nrow0 + n) * K + k0 + 8 * c) = o; }
    asm volatile("s_waitcnt lgkmcnt(0)" ::: "memory");
}

struct EpiWin {
    static constexpr bool PERM = true, AFTER_DRAIN = false;
    bf16_t *RQ, *RKD, *RV, *RG, *DQ, *DK, *DV; const float *cosr, *sinr, *cosd, *sind, *decay_logit;
    __device__ __forceinline__ void operator()(const f32x4 (&acc)[2][2][4][2], const Unit& u, int wr, int wc, int fr, int fq) const {
        const int g = u.pn >> 1, sub = u.pn & 1; const bool lat = u.pm < MLAT / 256;
        const int row0 = u.pm * 256 + wr * 64 + fr, ub = 32 * wc + 8 * fq;
        if (!lat && (g == 0 || g == 3 || g == 4)) return;
        if (g == 0 || g == 1 || g == 4 || g == 5) {
            const bool ret = g < 2;
            const int col1 = ret ? 256 * sub + 128 * (wc >> 1) + (ub & 63) : 256 * sub + 64 * wc + 8 * fq;
            const int col2 = col1 + (ret ? 64 : 32);
            const float* ct = ret ? cosr + (ub & 63) : cosd + 8 * fq; const float* st = ret ? sinr + (ub & 63) : sind + 8 * fq; const int tstr = ret ? 64 : 32;
            float l2g0 = 0.f, l2g1 = 0.f;
            if (g == 1) { const int h = 2 * sub + (wc >> 1); l2g0 = log_sigmoid(decay_logit[h]) * LOG2E; l2g1 = log_sigmoid(decay_logit[4 + h]) * LOG2E; }
#pragma unroll
            for (int ai = 0; ai < 2; ++ai)
#pragma unroll
                for (int m = 0; m < 4; ++m) {
                    const int row = row0 + 128 * ai + 16 * m;
                    const f32x4 x1a = acc[ai][0][m][0], x1b = acc[ai][0][m][1], x2a = acc[ai][1][m][0], x2b = acc[ai][1][m][1];
                    f32x4 o1a = x1a, o1b = x1b, o2a = x2a, o2b = x2b;
                    if (lat) { const int t = row & 4095; const f32x4 ca = *(const f32x4*)(ct + t * tstr), cb = *(const f32x4*)(ct + t * tstr + 4), sa = *(const f32x4*)(st + t * tstr), sb = *(const f32x4*)(st + t * tstr + 4);
                        o1a = x1a * ca - x2a * sa; o1b = x1b * cb - x2b * sb; o2a = x1a * sa + x2a * ca; o2b = x1b * sb + x2b * cb; }
                    if (g == 0) { store8(RQ + (size_t)row * 512 + col1, o1a, o1b); store8(RQ + (size_t)row * 512 + col2, o2a, o2b); }
                    else if (g == 1) { const int tc = row & 127; const float d0 = __builtin_amdgcn_exp2f(l2g0 * (float)(127 - tc)) * RKSCALE, d1 = __builtin_amdgcn_exp2f(l2g1 * (float)tc) * RKSCALE;
                        bf16_t* p0 = RKD + (size_t)row * 512; bf16_t* p1 = p0 + (size_t)MTOT * 512;
                        store8(p0 + col1, o1a * d0, o1b * d0); store8(p0 + col2, o2a * d0, o2b * d0); store8(p1 + col1, o1a * d1, o1b * d1); store8(p1 + col2, o2a * d1, o2b * d1); }
                    else if (g == 4) { store8(DQ + (size_t)row * 512 + col1, o1a * QSCALE, o1b * QSCALE); store8(DQ + (size_t)row * 512 + col2, o2a * QSCALE, o2b * QSCALE); }
                    else { const size_t kvrow = lat ? (size_t)(row >> 12) * KVL + 256 + (row & 4095) : (size_t)(u.pm - MLAT / 256) * KVL + (row & 255);
                        store8(DK + kvrow * 512 + col1, o1a, o1b); store8(DK + kvrow * 512 + col2, o2a, o2b); }
                }
        } else {
            const int col1 = 256 * sub + ub, col2 = col1 + 128;
#pragma unroll
            for (int ai = 0; ai < 2; ++ai)
#pragma unroll
                for (int m = 0; m < 4; ++m) {
                    const int row = row0 + 128 * ai + 16 * m;
                    if (g == 2) { store8(RV + (size_t)row * 512 + col1, acc[ai][0][m][0], acc[ai][0][m][1]); store8(RV + (size_t)row * 512 + col2, acc[ai][1][m][0], acc[ai][1][m][1]); }
                    else if (g == 3) { store8(RG + (size_t)row * 512 + col1, silu4(acc[ai][0][m][0]), silu4(acc[ai][0][m][1])); store8(RG + (size_t)row * 512 + col2, silu4(acc[ai][1][m][0]), silu4(acc[ai][1][m][1])); }
                    else { const size_t kvrow = lat ? (size_t)(row >> 12) * KVL + 256 + (row & 4095) : (size_t)(u.pm - MLAT / 256) * KVL + (row & 255);
                        store8(DV + kvrow * 512 + col1, acc[ai][0][m][0], acc[ai][0][m][1]); store8(DV + kvrow * 512 + col2, acc[ai][1][m][0], acc[ai][1][m][1]); }
                }
        }
    }
};


struct EpiWout {
    static constexpr bool PERM = false, AFTER_DRAIN = false;
    const float* x; const float* MOD; const float* GAM2; float* OUT; bf16_t* A2; float* rowss;
    __device__ __forceinline__ void operator()(const f32x4 (&acc)[2][2][4][2], const Unit& u, int wr, int wc, int fr, int fq) const {
        const int b = u.pm >> 4, col0 = u.pn * 256 + wc * 32 + 4 * fq, row0 = u.pm * 256 + wr * 64 + fr;
        f32x4 g1v[2][2], gm[2][2];
#pragma unroll
        for (int bj = 0; bj < 2; ++bj)
#pragma unroll
            for (int n = 0; n < 2; ++n) { g1v[bj][n] = *(const f32x4*)(MOD + b * NMOD + 2 * D + col0 + bj * 128 + n * 16); gm[bj][n] = *(const f32x4*)(GAM2 + b * D + col0 + bj * 128 + n * 16); }
#pragma unroll
        for (int ai = 0; ai < 2; ++ai)
#pragma unroll
            for (int m = 0; m < 4; ++m) { const int row = row0 + ai * 128 + m * 16; const size_t off = (size_t)row * D + col0; float s = 0.f;
#pragma unroll
                for (int bj = 0; bj < 2; ++bj)
#pragma unroll
                    for (int n = 0; n < 2; ++n) { const f32x4 xv = *(const f32x4*)(x + off + bj * 128 + n * 16); const f32x4 x1 = xv + g1v[bj][n] * acc[ai][bj][m][n];
                        *(f32x4*)(OUT + off + bj * 128 + n * 16) = x1; s += x1.x * x1.x + x1.y * x1.y + x1.z * x1.z + x1.w * x1.w; const f32x4 hq = x1 * gm[bj][n];
                        u32x2 w; w.x = cvt_pk_bf16(hq.x, hq.y); w.y = cvt_pk_bf16(hq.z, hq.w); *(u32x2*)(A2 + off + bj * 128 + n * 16) = w; }
                s += __shfl_xor(s, 16); s += __shfl_xor(s, 32);
                if (fq == 0) atomicAdd(rowss + row, s); }
    }
};
struct EpiUp {
    static constexpr bool PERM = true, AFTER_DRAIN = false;
    const float* rowss; const float* BIAS2; bf16_t* UH; int row_base;
    __device__ __forceinline__ void operator()(const f32x4 (&acc)[2][2][4][2], const Unit& u, int wr, int wc, int fr, int fq) const {
        const int b = (row_base + u.pm * 256) >> 12, ub = 32 * wc + 8 * fq, row0 = u.pm * 256 + wr * 64 + fr;
        f32x4 bv[2][2];
#pragma unroll
        for (int bj = 0; bj < 2; ++bj)
#pragma unroll
            for (int n = 0; n < 2; ++n) bv[bj][n] = *(const f32x4*)(BIAS2 + b * DFF2 + bj * DFF + 128 * u.pn + ub + 4 * n);
#pragma unroll
        for (int ai = 0; ai < 2; ++ai)
#pragma unroll
            for (int m = 0; m < 4; ++m) { const int row = row0 + ai * 128 + m * 16; const float rstd = rsqrtf(rowss[row_base + row] * (1.f / D) + EPS);
#pragma unroll
                for (int bj = 0; bj < 2; ++bj) store8(UH + (size_t)row * DFF2 + bj * DFF + 128 * u.pn + ub, acc[ai][bj][m][0] * rstd + bv[bj][0], acc[ai][bj][m][1] * rstd + bv[bj][1]); }
    }
};
struct EpiDown {
    static constexpr bool PERM = false, AFTER_DRAIN = false;
    const float* MOD; float* OUT;
    __device__ __forceinline__ void operator()(const f32x4 (&acc)[2][2][4][2], const Unit& u, int wr, int wc, int fr, int fq) const {
        const int b = u.pm >> 4, col0 = u.pn * 256 + wc * 32 + 4 * fq, row0 = u.pm * 256 + wr * 64 + fr;
        f32x4 g2v[2][2];
#pragma unroll
        for (int bj = 0; bj < 2; ++bj)
#pragma unroll
            for (int n = 0; n < 2; ++n) g2v[bj][n] = *(const f32x4*)(MOD + b * NMOD + 5 * D + col0 + bj * 128 + n * 16);
#pragma unroll
        for (int ai = 0; ai < 2; ++ai)
#pragma unroll
            for (int m = 0; m < 4; ++m) { const size_t off = (size_t)(row0 + ai * 128 + m * 16) * D + col0;
#pragma unroll
                for (int bj = 0; bj < 2; ++bj)
#pragma unroll
                    for (int n = 0; n < 2; ++n) { float* p = OUT + off + bj * 128 + n * 16; *(f32x4*)p = *(const f32x4*)p + g2v[bj][n] * acc[ai][bj][m][n]; } }
    }
};
__device__ __forceinline__ void cvt8(u32x4 w, float (&f)[8]) {
    f[0] = __uint_as_float(w.x << 16); f[1] = __uint_as_float(w.x & 0xffff0000u); f[2] = __uint_as_float(w.y << 16); f[3] = __uint_as_float(w.y & 0xffff0000u);
    f[4] = __uint_as_float(w.z << 16); f[5] = __uint_as_float(w.z & 0xffff0000u); f[6] = __uint_as_float(w.w << 16); f[7] = __uint_as_float(w.w & 0xffff0000u);
}


__device__ __forceinline__ void conv_phase(const bf16_t* __restrict__ UH, bf16_t* __restrict__ Gm, const float* __restrict__ conv_w, const float* __restrict__ conv_b, int row_base, int gt, int T) {
    const int groups = T / 352, rpg = (16384 + groups - 1) / groups;
    if (gt >= groups * 352) return;
    const int grp = gt / 352, jc = gt % 352, j0 = 8 * jc;
    float w0a[8], w1a[8], w2a[8], cba[8], w0b[8], w1b[8], w2b[8], cbb[8];
#pragma unroll
    for (int i = 0; i < 8; ++i) { w0a[i] = conv_w[j0 + i]; w0b[i] = conv_w[DFF + j0 + i]; w1a[i] = conv_w[DFF2 + j0 + i]; w1b[i] = conv_w[DFF2 + DFF + j0 + i];
        w2a[i] = conv_w[2 * DFF2 + j0 + i]; w2b[i] = conv_w[2 * DFF2 + DFF + j0 + i]; cba[i] = conv_b[j0 + i]; cbb[i] = conv_b[DFF + j0 + i]; }
    const int r0 = grp * rpg, r1 = (r0 + rpg < 16384) ? r0 + rpg : 16384;
    if (r0 >= r1) return;
    float pa[8], pb[8], ca[8], cb[8], na[8], nb[8];
    { const int t = (row_base + r0) & 4095;
      if (t > 0) { cvt8(*(const u32x4*)(UH + (size_t)(r0 - 1) * DFF2 + j0), pa); cvt8(*(const u32x4*)(UH + (size_t)(r0 - 1) * DFF2 + DFF + j0), pb); }
      else {
#pragma unroll
          for (int i = 0; i < 8; ++i) { pa[i] = 0.f; pb[i] = 0.f; } }
      cvt8(*(const u32x4*)(UH + (size_t)r0 * DFF2 + j0), ca); cvt8(*(const u32x4*)(UH + (size_t)r0 * DFF2 + DFF + j0), cb); }
    for (int r = r0; r < r1; ++r) {
        const int t = (row_base + r) & 4095;
        if (r + 1 < 16384) { cvt8(*(const u32x4*)(UH + (size_t)(r + 1) * DFF2 + j0), na); cvt8(*(const u32x4*)(UH + (size_t)(r + 1) * DFF2 + DFF + j0), nb); }
        else {
#pragma unroll
            for (int i = 0; i < 8; ++i) { na[i] = 0.f; nb[i] = 0.f; } }
        float o[8];
#pragma unroll
        for (int i = 0; i < 8; ++i) { const float pva = t > 0 ? pa[i] : 0.f, pvb = t > 0 ? pb[i] : 0.f, nva = t < 4095 ? na[i] : 0.f, nvb = t < 4095 ? nb[i] : 0.f;
            const float a = cba[i] + w0a[i] * pva + w1a[i] * ca[i] + w2a[i] * nva, bq = cbb[i] + w0b[i] * pvb + w1b[i] * cb[i] + w2b[i] * nvb; o[i] = siluf(a) * bq; }
        u32x4 w; w.x = cvt_pk_bf16(o[0], o[1]); w.y = cvt_pk_bf16(o[2], o[3]); w.z = cvt_pk_bf16(o[4], o[5]); w.w = cvt_pk_bf16(o[6], o[7]);
        *(u32x4*)(Gm + (size_t)(row_base + r) * DFF + j0) = w;
#pragma unroll
        for (int i = 0; i < 8; ++i) { pa[i] = ca[i]; pb[i] = cb[i]; ca[i] = na[i]; cb[i] = nb[i]; }
    }
}

__global__ void __launch_bounds__(NTHR, 2) mk_fwd(Args args) {
    extern __shared__ __attribute__((aligned(16))) unsigned char lds_raw[];
    LAS unsigned char* lds = (LAS unsigned char*)lds_raw;
    cg::grid_group grid = cg::this_grid();
    const int tid = threadIdx.x, lane = tid & 63, wave = __builtin_amdgcn_readfirstlane(tid >> 6), wg = blockIdx.x, G = gridDim.x;
    unsigned char* ws = args.ws;
    const float* x = args.in[0]; const float* c = args.in[1]; const float* ctx = args.in[2]; const float* c_ctx = args.in[3];
    const float* w_mod = args.in[4]; const float* b_mod = args.in[5]; const float* norm1_g = args.in[6]; const float* w_in = args.in[7];
    const float* decay_logit = args.in[8]; const float* diff_lambda = args.in[10];
    const float* w_out = args.in[12]; const float* norm2_g = args.in[13]; const float* w_up = args.in[14]; const float* w_down = args.in[17];
    float* MOD = (float*)(ws + WS_MOD); float* GAM2 = (float*)(ws + WS_GAM2); float* BIAS2 = (float*)(ws + WS_BIAS2); float* MISC = (float*)(ws + WS_MISC);
    float* cosr = (float*)(ws + WS_COSR); float* sinr = (float*)(ws + WS_SINR); float* cosd = (float*)(ws + WS_COSD); float* sind = (float*)(ws + WS_SIND);
    bf16_t* WinT = (bf16_t*)(ws + WS_WIN); bf16_t* WoutT = (bf16_t*)(ws + WS_WOUT); bf16_t* WupT = (bf16_t*)(ws + WS_WUP); bf16_t* WdownT = (bf16_t*)(ws + WS_WDOWN);
    bf16_t* XN = (bf16_t*)(ws + WS_XN); bf16_t* YA = (bf16_t*)(ws + WS_YA); bf16_t* A2 = (bf16_t*)(ws + WS_A2); bf16_t* UH = (bf16_t*)(ws + WS_UH); bf16_t* Gb = (bf16_t*)(ws + WS_G); float* rowss = (float*)(ws + WS_ROWSS);
    const float* gn_g = args.in[9]; const float* subln_g = args.in[11]; const float* conv_w = args.in[15]; const float* conv_b = args.in[16]; const float* final_g = args.in[18];
    const int lo = args.ph_lo, hi = args.ph_hi;
#define IN(k) (lo <= (k) && (k) < hi)
#define SEAM(k) do { if (IN(k) && IN((k) + 1)) grid.sync(); } while (0)

    if (IN(0)) {
        LAS float* sc = (LAS float*)lds; LAS float* red = sc + 9 * 1024;
        for (int i = tid; i < 9 * 1024; i += NTHR) { const int r = i >> 10, k = i & 1023; sc[i] = siluf(r < 8 ? c[r * D + k] : c_ctx[k]); }
        __syncthreads();
        for (int cw = wg; cw < 256; cw += G) {
            const int ks = tid / 24, col = tid % 24;
            if (tid < 504) {
                float a[9];
#pragma unroll
                for (int r = 0; r < 9; ++r) a[r] = 0.f;
                for (int k = ks; k < D; k += 21) { const float w = w_mod[(size_t)k * NMOD + 24 * cw + col];
#pragma unroll
                    for (int r = 0; r < 9; ++r) a[r] += sc[r * 1024 + k] * w; }
#pragma unroll
                for (int r = 0; r < 9; ++r) red[(ks * 24 + col) * 9 + r] = a[r];
            }
            __syncthreads();
            if (tid < 216) { const int cc = tid / 9, r = tid % 9; float s = 0.f; for (int q = 0; q < 21; ++q) s += red[(q * 24 + cc) * 9 + r]; MOD[r * NMOD + 24 * cw + cc] = s + b_mod[24 * cw + cc]; }
            __syncthreads();
        }
        {
            LAS float* scr = (LAS float*)(lds + wave * 8448);
            constexpr int I_IN = 16 * (INC / 32), I_OUT = 16 * (D / 32), I_UP = 16 * (DFF2 / 32), I_DN = (DFF / 64) * (D / 32), NIT = I_IN + I_OUT + I_UP + I_DN;
            for (int it = wg * NWAVES + wave; it < NIT; it += G * NWAVES) {
                int r = it;
                if (r < I_IN) { const int nb = r % (INC / 32), kb = r / (INC / 32); transpose_item(w_in, D, INC, WinT, 64 * kb, 32 * nb, colmap_in(32 * nb), scr, lane); continue; } r -= I_IN;
                if (r < I_OUT) { const int nb = r % (D / 32), kb = r / (D / 32); transpose_item(w_out, D, D, WoutT, 64 * kb, 32 * nb, 32 * nb, scr, lane); continue; } r -= I_OUT;
                if (r < I_UP) { const int nb = r % (DFF2 / 32), kb = r / (DFF2 / 32); transpose_item(w_up, D, DFF2, WupT, 64 * kb, 32 * nb, colmap_up(32 * nb), scr, lane); continue; } r -= I_UP;
                { const int nb = r % (D / 32), kb = r / (D / 32); transpose_item(w_down, DFF, D, WdownT, 64 * kb, 32 * nb, 32 * nb, scr, lane); }
            }
        }
        for (int idx = wg * NTHR + tid; idx < SEQ * 96; idx += G * NTHR) {
            if (idx < SEQ * 64) { const int pos = idx >> 6, j = idx & 63; const float inv = powf(10000.f, -(float)(j & 31) / 32.f); const float p = (j < 32) ? (float)(pos >> 6) : (float)(pos & 63); const float a = p * inv; cosr[idx] = cosf(a); sinr[idx] = sinf(a); }
            else { const int i2 = idx - SEQ * 64, pos = i2 >> 5, j = i2 & 31; const float inv = powf(10000.f, -(float)(j & 15) / 16.f); const float p = (j < 16) ? (float)(pos >> 6) : (float)(pos & 63); const float a = p * inv; cosd[i2] = cosf(a); sind[i2] = sinf(a); }
        }
        if (wg == 0 && tid == 0) { float a = 0.f, bb = 0.f; for (int i = 0; i < 64; ++i) { a += diff_lambda[i] * diff_lambda[64 + i]; bb += diff_lambda[128 + i] * diff_lambda[192 + i]; } MISC[0] = expf(a) - expf(bb) + LAMBDA_INIT; }
        __syncthreads();
    }
    SEAM(0);
    if (IN(1)) {
        const int nwv = G * NWAVES, gw = wg * NWAVES + wave, rpw = (MTOT + nwv - 1) / nwv;
        int curb = -1; f32x4 gam[4], shv[4];
        for (int m = gw * rpw; m < (gw + 1) * rpw && m < MTOT; ++m) {
            const int r = m < MLAT ? (m >> 12) : 8;
            if (r != curb) { curb = r; const float* sh = MOD + r * NMOD; const float* scp = sh + D;
#pragma unroll
                for (int j = 0; j < 4; ++j) { const int k = 4 * lane + 256 * j; gam[j] = *(const f32x4*)(norm1_g + k) * (1.f + *(const f32x4*)(scp + k)); shv[j] = *(const f32x4*)(sh + k); } }
            const float* xr = m < MLAT ? x + (size_t)m * D : ctx + (size_t)(m - MLAT) * D;
            f32x4 v[4]; float s = 0.f;
#pragma unroll
            for (int j = 0; j < 4; ++j) { v[j] = *(const f32x4*)(xr + 4 * lane + 256 * j); s += v[j].x * v[j].x + v[j].y * v[j].y + v[j].z * v[j].z + v[j].w * v[j].w; }
            const float rstd = rsqrtf(wave_sum(s) * (1.f / D) + EPS);
#pragma unroll
            for (int j = 0; j < 4; ++j) { const f32x4 h = v[j] * rstd * gam[j] + shv[j]; u32x2 w; w.x = cvt_pk_bf16(h.x, h.y); w.y = cvt_pk_bf16(h.z, h.w); *(u32x2*)(XN + (size_t)m * D + 4 * lane + 256 * j) = w; }
        }
        const int gt = wg * NTHR + tid;
        if (gt < NB * D) { const int b = gt / D, k = gt % D; GAM2[gt] = norm2_g[k] * (1.f + MOD[b * NMOD + 4 * D + k]); }
        else if (gt < NB * D + DFF2) { const int n = gt - NB * D; float a[8];
#pragma unroll
            for (int b = 0; b < 8; ++b) a[b] = 0.f;
            for (int k = 0; k < D; ++k) { const float w = w_up[(size_t)k * DFF2 + n];
#pragma unroll
                for (int b = 0; b < 8; ++b) a[b] += MOD[b * NMOD + 3 * D + k] * w; }
#pragma unroll
            for (int b = 0; b < 8; ++b) BIAS2[b * DFF2 + n] = a[b]; }
    }
    SEAM(1);
    if (IN(2)) {
        Gemm g{XN, WinT, MTOT, INC, D}; StaticOrder S; S.init(MTOT, INC, G, wg);
        EpiWin E{(bf16_t*)(ws + WS_RQ), (bf16_t*)(ws + WS_RKD), (bf16_t*)(ws + WS_RV), (bf16_t*)(ws + WS_RG), (bf16_t*)(ws + WS_DQ), (bf16_t*)(ws + WS_DK), (bf16_t*)(ws + WS_DV), cosr, sinr, cosd, sind, decay_logit};
        pg8::gemm_phase<EpiWin, StaticOrder, true, true>(lds, g, S, E);
    }
    SEAM(2);
    SEAM(3);
    if (IN(4)) {
        const bf16_t* RQ = (const bf16_t*)(ws + WS_RQ); const bf16_t* RKD = (const bf16_t*)(ws + WS_RKD); const bf16_t* RV = (const bf16_t*)(ws + WS_RV); const bf16_t* RG = (const bf16_t*)(ws + WS_RG);
        const bf16_t* DQ = (const bf16_t*)(ws + WS_DQ); const bf16_t* DK = (const bf16_t*)(ws + WS_DK); const bf16_t* DV = (const bf16_t*)(ws + WS_DV);
        float* TMP = (float*)(ws + WS_TMP);
        for (int unit = wg; unit < 32; unit += G) {
            LAS float* qs = (LAS float*)lds; LAS float* ks = qs + 128; LAS float* red = ks + 128;
            const int b = unit >> 2, h = unit & 3, e = tid & 127; const bool act = tid < 128;
            for (int d = 0; d < 2; ++d) {
                const float lg = log_sigmoid(decay_logit[d * 4 + h]), gam = expf(lg); const float gg = gn_g[d * 512 + h * 128 + e];
                const bf16_t* KD = RKD + (size_t)d * MTOT * 512;
                float S[128];
#pragma unroll
                for (int i = 0; i < 128; ++i) S[i] = 0.f;
                for (int step = 0; step < KVL; ++step) {
                    const bool isctx = step < CTXL; const int tt = isctx ? step : step - CTXL; const int L = isctx ? CTXL : SEQ;
                    const int t = d == 0 ? tt : L - 1 - tt; const int m = isctx ? MLAT + b * CTXL + t : b * SEQ + t; const int tc = t & 127;
                    const float undo = expf(-lg * (float)(d == 0 ? 127 - tc : tc));
                    __syncthreads();
                    if (act) { ks[e] = bf2f(KD[(size_t)m * 512 + h * 128 + e]) * undo; qs[e] = isctx ? 0.f : bf2f(RQ[(size_t)m * 512 + h * 128 + e]); }
                    const float v = bf2f(RV[(size_t)m * 512 + h * 128 + e]);
                    __syncthreads();
                    float oo = 0.f;
#pragma unroll
                    for (int i = 0; i < 128; ++i) { S[i] = gam * S[i] + ks[i] * v; oo += qs[i] * S[i]; }
                    if (!isctx) {
                        const float s1 = wave_sum(oo), s2 = wave_sum(oo * oo);
                        if (act && (e & 63) == 0) { red[(e >> 6) * 2] = s1; red[(e >> 6) * 2 + 1] = s2; }
                        __syncthreads();
                        const float mu = (red[0] + red[2]) * (1.f / 128.f); const float var = (red[1] + red[3]) * (1.f / 128.f) - mu * mu;
                        const float on = (oo - mu) * rsqrtf(var + GN_EPS) * gg;
                        const size_t off = (size_t)m * 512 + h * 128 + e;
                        if (act) { if (d == 0) TMP[off] = on; else YA[(size_t)m * 1024 + h * 128 + e] = f2bf(bf2f(RG[off]) * (TMP[off] + on)); }
                    }
                }
            }
            __syncthreads();
        }
        for (int unit = wg; unit < 1024; unit += G) {
            const int h = unit & 3, blk = unit >> 2, qi = tid >> 2, mp = (tid >> 1) & 1, hf = tid & 1, m = blk * 128 + qi, b = m >> 12;
            float q[64], o[64];
            const bf16_t* qp = DQ + (size_t)m * 512 + h * 128 + mp * 64;
#pragma unroll
            for (int i = 0; i < 64; ++i) { q[i] = bf2f(qp[i]); o[i] = 0.f; }
            float mx = -1e30f, l = 0.f;
            const bf16_t* kb = DK + (size_t)b * KVL * 512 + h * 128 + mp * 64; const bf16_t* vb = DV + (size_t)b * KVL * 512 + h * 128 + hf * 64;
            for (int j = 0; j < KVL; ++j) {
                float kf[8], s = 0.f;
#pragma unroll
                for (int i = 0; i < 64; i += 8) { cvt8(*(const u32x4*)(kb + (size_t)j * 512 + i), kf);
#pragma unroll
                    for (int z = 0; z < 8; ++z) s += q[i + z] * kf[z]; }
                if (s > mx) { const float a = exp2f(mx - s); l *= a;
#pragma unroll
                    for (int i = 0; i < 64; ++i) o[i] *= a;
                    mx = s; }
                const float p = exp2f(s - mx); l += p;
#pragma unroll
                for (int i = 0; i < 64; i += 8) { cvt8(*(const u32x4*)(vb + (size_t)j * 512 + i), kf);
#pragma unroll
                    for (int z = 0; z < 8; ++z) o[i + z] += p * kf[z]; }
            }
            const float lam = MISC[0], rl = 1.f / l; float ss = 0.f;
#pragma unroll
            for (int i = 0; i < 64; ++i) { const float mine = o[i] * rl, other = __shfl_xor(mine, 2); const float dd = mp == 0 ? mine - lam * other : other - lam * mine; o[i] = dd; ss += dd * dd; }
            ss += __shfl_xor(ss, 1);
            const float rs = rsqrtf(ss * (1.f / 128.f) + EPS) * (1.f - LAMBDA_INIT);
            if (mp == 0) { bf16_t* yo = YA + (size_t)m * 1024 + 512 + h * 128 + hf * 64; const float* gg = subln_g + h * 128 + hf * 64;
#pragma unroll
                for (int i = 0; i < 64; ++i) yo[i] = f2bf(o[i] * rs * gg[i]); }
        }
    }
    SEAM(4);
    if (IN(5)) {
        Gemm g{YA, WoutT, MLAT, D, D}; StaticOrder S; S.init(MLAT, D, G, wg);
        EpiWout E{x, MOD, GAM2, args.out, A2, rowss};
        pg8::gemm_phase<EpiWout, StaticOrder, true, true>(lds, g, S, E);
    }
    SEAM(5);
#define UP_HALF(hf) do { \
        if (IN(6 + 2 * (hf))) { \
            Gemm g{A2 + (size_t)(hf) * 16384 * D, WupT, 16384, DFF2, D}; StaticOrder S; S.init(16384, DFF2, G, wg); \
            EpiUp E{rowss, BIAS2, UH, (hf) * 16384}; \
            pg8::gemm_phase<EpiUp, StaticOrder, true, true>(lds, g, S, E); \
        } \
        SEAM(6 + 2 * (hf)); \
        if (IN(7 + 2 * (hf))) conv_phase(UH, Gb, conv_w, conv_b, (hf) * 16384, wg * NTHR + tid, G * NTHR); \
        SEAM(7 + 2 * (hf)); } while (0)
    UP_HALF(0);
    UP_HALF(1);
#undef UP_HALF
    if (IN(10)) {
        Gemm g{Gb, WdownT, MLAT, D, DFF}; StaticOrder S; S.init(MLAT, D, G, wg);
        EpiDown E{MOD, args.out};
        pg8::gemm_phase<EpiDown, StaticOrder, true, true>(lds, g, S, E);
    }
    SEAM(10);
    if (IN(11)) {
        const int nwv = G * NWAVES;
        for (int m = wg * NWAVES + wave; m < MLAT; m += nwv) {
            float* xr = args.out + (size_t)m * D; f32x4 v[4]; float s = 0.f;
#pragma unroll
            for (int j = 0; j < 4; ++j) { v[j] = *(const f32x4*)(xr + 4 * lane + 256 * j); s += v[j].x * v[j].x + v[j].y * v[j].y + v[j].z * v[j].z + v[j].w * v[j].w; }
            const float rstd = rsqrtf(wave_sum(s) * (1.f / D) + EPS);
#pragma unroll
            for (int j = 0; j < 4; ++j) *(f32x4*)(xr + 4 * lane + 256 * j) = v[j] * rstd * *(const f32x4*)(final_g + 4 * lane + 256 * j);
        }
    }
#undef IN
#undef SEAM
}
}
#ifndef OPT_LEVEL
#define OPT_LEVEL 2
#endif
static int mk_grid = 0;
static void mk_launch(mk::Args a, int lo, int hi, hipStream_t stream) {
    a.ph_lo = lo; a.ph_hi = hi; void* args[] = {&a};
    hipError_t e = hipLaunchCooperativeKernel((const void*)mk::mk_fwd, dim3(mk_grid), dim3(mk::NTHR), args, mk::LDS_BYTES, stream);
    if (e != hipSuccess) fprintf(stderr, "cooperative launch failed: %s (grid %d)\n", hipGetErrorString(e), mk_grid);
}
extern "C" void kernel_launch(void* const* d_in, const int* in_sizes, int n_in, void* d_out, int out_size, void* d_ws, size_t ws_size, hipStream_t stream) {
    if (ws_size < WS_END || n_in != 19) { fprintf(stderr, "kernel_launch: ws too small %zu or n_in %d\n", ws_size, n_in); return; }
    if (mk_grid == 0) {
        int dev = 0, cus = 0, per_cu = 0; (void)hipGetDevice(&dev); (void)hipDeviceGetAttribute(&cus, hipDeviceAttributeMultiprocessorCount, dev);
        if (hipFuncSetAttribute((const void*)mk::mk_fwd, hipFuncAttributeMaxDynamicSharedMemorySize, mk::LDS_BYTES) != hipSuccess) fprintf(stderr, "hipFuncSetAttribute failed\n");
        if (hipOccupancyMaxActiveBlocksPerMultiprocessor(&per_cu, (const void*)mk::mk_fwd, mk::NTHR, mk::LDS_BYTES) != hipSuccess || per_cu < 1) { fprintf(stderr, "occupancy query: %d\n", per_cu); per_cu = 1; }
        if (per_cu > 1) per_cu = 1;
        mk_grid = cus * per_cu; fprintf(stderr, "mk grid = %d (cus %d)\n", mk_grid, cus);
    }
    const float* x = (const float*)d_in[0]; const float* c = (const float*)d_in[1]; const float* ctx = (const float*)d_in[2]; const float* c_ctx = (const float*)d_in[3];
    const float* w_mod = (const float*)d_in[4]; const float* b_mod = (const float*)d_in[5]; const float* norm1_g = (const float*)d_in[6]; const float* w_in = (const float*)d_in[7];
    const float* decay_logit = (const float*)d_in[8]; const float* gn_g = (const float*)d_in[9]; const float* diff_lambda = (const float*)d_in[10]; const float* subln_g = (const float*)d_in[11];
    const float* w_out = (const float*)d_in[12]; const float* norm2_g = (const float*)d_in[13]; const float* w_up = (const float*)d_in[14]; const float* conv_w = (const float*)d_in[15];
    const float* conv_b = (const float*)d_in[16]; const float* w_down = (const float*)d_in[17]; const float* final_g = (const float*)d_in[18];
    char* ws = (char*)d_ws; float* out = (float*)d_out;
    float* MOD = (float*)(ws + WS_MOD); float* GAM2 = (float*)(ws + WS_GAM2); float* BIAS2 = (float*)(ws + WS_BIAS2); float* MISC = (float*)(ws + WS_MISC); float* rowss = (float*)(ws + WS_ROWSS);
    float* cosr = (float*)(ws + WS_COSR); float* sinr = (float*)(ws + WS_SINR); float* cosd = (float*)(ws + WS_COSD); float* sind = (float*)(ws + WS_SIND);
    bf16_t* XN = (bf16_t*)(ws + WS_XN); float* TMP = (float*)(ws + WS_TMP); bf16_t* A2 = (bf16_t*)(ws + WS_A2);
    bf16_t* YA = (bf16_t*)(ws + WS_YA); bf16_t* G = (bf16_t*)(ws + WS_G); bf16_t* UH = (bf16_t*)(ws + WS_UH);
    nv::P1Out po{(bf16_t*)(ws + WS_RQ), (bf16_t*)(ws + WS_RKD), (bf16_t*)(ws + WS_RV), (bf16_t*)(ws + WS_RG), (bf16_t*)(ws + WS_DQ), (bf16_t*)(ws + WS_DK), (bf16_t*)(ws + WS_DV), cosr, sinr, cosd, sind, decay_logit};
    mk::Args a{}; for (int i = 0; i < 19; ++i) a.in[i] = (const float*)d_in[i]; a.out = out; a.ws = (unsigned char*)d_ws;
    (void)hipMemsetAsync(ws + WS_ZERO, 0, ZERO_BYTES, stream);
#if OPT_LEVEL == 3
    mk_launch(a, 0, 3, stream);
    nv::k_ret<<<32, 128, 0, stream>>>(po.RQ, po.RKD, po.RV, po.RG, decay_logit, gn_g, TMP, YA);
    nv::k_attn<<<dim3(MLAT / 64, 4), 256, 0, stream>>>(po.DQ, po.DK, po.DV, subln_g, MISC, YA);
    mk_launch(a, 5, 12, stream);
    return;
#elif OPT_LEVEL == 2
    mk_launch(a, 0, 12, stream);
    return;
#elif OPT_LEVEL >= 1
    mk_launch(a, 0, 3, stream);
#else
    nv::k_mod<<<(9 * NMOD + 255) / 256, 256, 0, stream>>>(c, c_ctx, w_mod, b_mod, MOD);
    nv::k_small<<<(SEQ * 64 + 255) / 256, 256, 0, stream>>>(MOD, norm2_g, w_up, diff_lambda, GAM2, BIAS2, MISC, cosr, sinr, cosd, sind);
    nv::k_xn<<<MTOT / 4, 256, 0, stream>>>(x, ctx, MOD, norm1_g, XN);
    { float* scr = (float*)(ws + WS_SCR);
    for (int g = 0; g < 7; ++g) {
        nv::k_gemm<<<dim3(512 / 64, MTOT / 64), 256, 0, stream>>>(XN, D, w_in, INC, 512 * g, scr, 512, D);
        nv::k_p1post<<<MTOT, 256, 0, stream>>>(scr, g, po);
    } }
#endif
    nv::k_ret<<<32, 128, 0, stream>>>(po.RQ, po.RKD, po.RV, po.RG, decay_logit, gn_g, TMP, YA);
    nv::k_attn<<<dim3(MLAT / 64, 4), 256, 0, stream>>>(po.DQ, po.DK, po.DV, subln_g, MISC, YA);
    float* scr2 = (float*)(ws + WS_SCR2);
    nv::k_gemm<<<dim3(D / 64, MLAT / 64), 256, 0, stream>>>(YA, D, w_out, D, 0, scr2, D, D);
    nv::k_post_wout<<<MLAT / 4, 256, 0, stream>>>(scr2, x, MOD, GAM2, out, A2, rowss);
    float* scr3 = (float*)(ws + WS_SCR3);
    for (int hf = 0; hf < 2; ++hf) {
        for (int nb = 0; nb < DFF2 / 512; ++nb) {
            nv::k_gemm<<<dim3(512 / 64, 16384 / 64), 256, 0, stream>>>(A2 + (size_t)hf * 16384 * D, D, w_up, DFF2, 512 * nb, scr3, 512, D);
            nv::k_post_up<<<16384, 256, 0, stream>>>(scr3, 512 * nb, hf * 16384, rowss, BIAS2, UH);
        }
        nv::k_conv<<<16384, 256, 0, stream>>>(UH, hf * 16384, conv_w, conv_b, G);
    }
    float* scr4 = (float*)(ws + WS_SCR4);
    nv::k_gemm<<<dim3(D / 64, MLAT / 64), 256, 0, stream>>>(G, DFF, w_down, D, 0, scr4, D, DFF);
    nv::k_post_down<<<MLAT / 4, 256, 0, stream>>>(scr4, MOD, final_g, out);
}
```

```cpp
#include <hip/hip_runtime.h>
#include <hip/hip_bf16.h>
#include <cstdio>
#include <cstdint>

typedef unsigned short bf16_t;
typedef float f32x4 __attribute__((ext_vector_type(4)));
typedef unsigned u32x4 __attribute__((ext_vector_type(4)));
typedef unsigned u32x2 __attribute__((ext_vector_type(2)));

constexpr int D = 1024, NB = 8, SEQ = 4096, CTXL = 256, MLAT = NB * SEQ, MCTX = NB * CTXL, MTOT = MLAT + MCTX;
constexpr int INC = 3584, DFF = 2816, DFF2 = 5632, KVL = SEQ + CTXL, NMOD = 6 * D;
constexpr float EPS = 1e-6f, GN_EPS = 1e-5f;
constexpr float LAMBDA_INIT = 0.2f;
constexpr float QSCALE = 0.125f * 1.4426950408889634f;
constexpr float RKSCALE = 0.088388347648318440f;

constexpr size_t MiB = 1u << 20;
constexpr size_t WS_ZERO = 0, ZERO_BYTES = 1 * MiB;
constexpr size_t WS_ROWSS = 0;
constexpr size_t WS_MISC = 512 * 1024;
constexpr size_t WS_MOD = 1 * MiB;
constexpr size_t WS_GAM2 = WS_MOD + 256 * 1024;
constexpr size_t WS_BIAS2 = WS_GAM2 + 64 * 1024;
constexpr size_t WS_ROPE = 2 * MiB;
constexpr size_t WS_COSR = WS_ROPE, WS_SINR = WS_ROPE + 1 * MiB, WS_COSD = WS_ROPE + 2 * MiB, WS_SIND = WS_COSD + 512 * 1024;
constexpr size_t WS_MODP = 5 * MiB;
constexpr size_t WS_WIN = 10 * MiB, WS_WOUT = 18 * MiB, WS_WUP = 20 * MiB, WS_WDOWN = 32 * MiB;
constexpr size_t WS_RA = 40 * MiB;
constexpr size_t WS_XN = WS_RA, WS_TMP = WS_RA, WS_A2 = WS_RA + 1 * MiB;
constexpr size_t WS_RQ = 112 * MiB;
constexpr size_t WS_RKD = WS_RQ + 32 * MiB;
constexpr size_t WS_RV = WS_RKD + 68 * MiB;
constexpr size_t WS_RG = WS_RV + 34 * MiB;
constexpr size_t WS_DQ = WS_RG + 32 * MiB;
constexpr size_t WS_DK = WS_DQ + 32 * MiB;
constexpr size_t WS_DV = WS_DK + 34 * MiB;
constexpr size_t WS_E = WS_DV + 34 * MiB;
constexpr size_t WS_YA = 414 * MiB;
constexpr size_t WS_SCR = 414 * MiB;
constexpr size_t WS_G = 112 * MiB;
constexpr size_t WS_UH = 288 * MiB;
constexpr size_t WS_SCR2 = 112 * MiB;
constexpr size_t WS_SCR3 = 464 * MiB;
constexpr size_t WS_SCR4 = 288 * MiB;
constexpr size_t WS_END = 512 * MiB;
static_assert(WS_E == 378 * MiB, "map");

__device__ __forceinline__ float bf2f(bf16_t v) { return __uint_as_float((unsigned)v << 16); }
__device__ __forceinline__ bf16_t f2bf(float f) { unsigned u = __float_as_uint(f); return (bf16_t)((u + 0x7fffu + ((u >> 16) & 1u)) >> 16); }
__device__ __forceinline__ float siluf(float v) { return v / (1.f + __expf(-v)); }
__device__ __forceinline__ float wave_sum(float v) {
#pragma unroll
    for (int o = 1; o < 64; o <<= 1) v += __shfl_xor(v, o);
    return v;
}
__device__ __forceinline__ int lane_now() { int l; asm volatile("v_mbcnt_lo_u32_b32 %0, -1, 0\n\tv_mbcnt_hi_u32_b32 %0, -1, %0" : "=v"(l)); return l; }
__device__ __forceinline__ float log_sigmoid(float x) { return -log1pf(expf(-x)); }

namespace nv {
__global__ void __launch_bounds__(256) k_mod(const float* __restrict__ c, const float* __restrict__ c_ctx, const float* __restrict__ w_mod, const float* __restrict__ b_mod, float* __restrict__ MOD) {
    const int idx = blockIdx.x * 256 + threadIdx.x;
    if (idx >= 9 * NMOD) return;
    const int r = idx / NMOD, j = idx % NMOD;
    const float* cv = r < 8 ? c + r * D : c_ctx;
    float s = 0.f;
    for (int k = 0; k < D; ++k) s += siluf(cv[k]) * w_mod[(size_t)k * NMOD + j];
    MOD[idx] = s + b_mod[j];
}
__global__ void __launch_bounds__(256) k_small(const float* __restrict__ MOD, const float* __restrict__ norm2_g, const float* __restrict__ w_up, const float* __restrict__ diff_lambda,
                                               float* __restrict__ GAM2, float* __restrict__ BIAS2, float* __restrict__ MISC, float* cosr, float* sinr, float* cosd, float* sind) {
    const int idx = blockIdx.x * 256 + threadIdx.x;
    if (idx < NB * D) { const int b = idx / D, k = idx % D; GAM2[idx] = norm2_g[k] * (1.f + MOD[b * NMOD + 4 * D + k]); }
    if (idx < NB * DFF2) { const int b = idx / DFF2, n = idx % DFF2; float s = 0.f; for (int k = 0; k < D; ++k) s += MOD[b * NMOD + 3 * D + k] * w_up[(size_t)k * DFF2 + n]; BIAS2[idx] = s; }
    if (idx == 0) { float a = 0.f, bb = 0.f; for (int i = 0; i < 64; ++i) { a += diff_lambda[i] * diff_lambda[64 + i]; bb += diff_lambda[128 + i] * diff_lambda[192 + i]; } MISC[0] = expf(a) - expf(bb) + LAMBDA_INIT; }
    if (idx < SEQ * 64) { const int pos = idx >> 6, j = idx & 63; const float inv = powf(10000.f, -(float)(j & 31) / 32.f); const float p = (j < 32) ? (float)(pos >> 6) : (float)(pos & 63); const float a = p * inv; cosr[idx] = cosf(a); sinr[idx] = sinf(a); }
    if (idx < SEQ * 32) { const int pos = idx >> 5, j = idx & 31; const float inv = powf(10000.f, -(float)(j & 15) / 16.f); const float p = (j < 16) ? (float)(pos >> 6) : (float)(pos & 63); const float a = p * inv; cosd[idx] = cosf(a); sind[idx] = sinf(a); }
}
__global__ void __launch_bounds__(256) k_xn(const float* __restrict__ x, const float* __restrict__ ctx, const float* __restrict__ MOD, const float* __restrict__ g, bf16_t* __restrict__ XN) {
    const int lane = threadIdx.x & 63, m = blockIdx.x * 4 + (threadIdx.x >> 6);
    if (m >= MTOT) return;
    const float* xr = m < MLAT ? x + (size_t)m * D : ctx + (size_t)(m - MLAT) * D;
    const int r = m < MLAT ? (m >> 12) : 8;
    const float* sh = MOD + r * NMOD, * sc = sh + D;
    f32x4 v[4]; float s = 0.f;
#pragma unroll
    for (int j = 0; j < 4; ++j) { v[j] = *(const f32x4*)(xr + 4 * lane + 256 * j); s += v[j].x * v[j].x + v[j].y * v[j].y + v[j].z * v[j].z + v[j].w * v[j].w; }
    const float rstd = rsqrtf(wave_sum(s) * (1.f / D) + EPS);
#pragma unroll
    for (int j = 0; j < 4; ++j) { const int k = 4 * lane + 256 * j; const f32x4 gg = *(const f32x4*)(g + k), a = *(const f32x4*)(sc + k), bq = *(const f32x4*)(sh + k);
        const f32x4 h = v[j] * rstd * gg * (1.f + a) + bq;
        u32x2 w; w.x = f2bf(h.x) | ((unsigned)f2bf(h.y) << 16); w.y = f2bf(h.z) | ((unsigned)f2bf(h.w) << 16); *(u32x2*)(XN + (size_t)m * D + k) = w; }
}
__global__ void __launch_bounds__(256) k_gemm(const bf16_t* __restrict__ A, int lda, const float* __restrict__ W, int ldw, int n0, float* __restrict__ C, int ldc, int K) {
    __shared__ float As[16][65], Bs[16][65];
    const int tx = threadIdx.x & 15, ty = threadIdx.x >> 4, m0 = blockIdx.y * 64, nb = blockIdx.x * 64;
    float acc[4][4];
#pragma unroll
    for (int i = 0; i < 4; ++i)
#pragma unroll
        for (int j = 0; j < 4; ++j) acc[i][j] = 0.f;
    for (int k0 = 0; k0 < K; k0 += 16) {
#pragma unroll
        for (int i = 0; i < 4; ++i) { const int e = threadIdx.x + 256 * i, r = e >> 4, cc = e & 15; As[cc][r] = bf2f(A[(size_t)(m0 + r) * lda + k0 + cc]); }
#pragma unroll
        for (int i = 0; i < 4; ++i) { const int e = threadIdx.x + 256 * i, r = e >> 6, cc = e & 63; Bs[r][cc] = W[(size_t)(k0 + r) * ldw + n0 + nb + cc]; }
        __syncthreads();
#pragma unroll
        for (int kk = 0; kk < 16; ++kk) { float a[4], b[4];
#pragma unroll
            for (int i = 0; i < 4; ++i) { a[i] = As[kk][ty * 4 + i]; b[i] = Bs[kk][tx * 4 + i]; }
#pragma unroll
            for (int i = 0; i < 4; ++i)
#pragma unroll
                for (int j = 0; j < 4; ++j) acc[i][j] += a[i] * b[j]; }
        __syncthreads();
    }
#pragma unroll
    for (int i = 0; i < 4; ++i) *(f32x4*)(C + (size_t)(m0 + ty * 4 + i) * ldc + nb + tx * 4) = (f32x4){acc[i][0], acc[i][1], acc[i][2], acc[i][3]};
}
struct P1Out { bf16_t *RQ, *RKD, *RV, *RG, *DQ, *DK, *DV; const float *cosr, *sinr, *cosd, *sind; const float* decay_logit; };
__global__ void __launch_bounds__(256) k_p1post(const float* __restrict__ P, int g, P1Out o) {
    const int m = blockIdx.x, c = threadIdx.x;
    const bool lat = m < MLAT; const int b = lat ? (m >> 12) : ((m - MLAT) >> 8), t = lat ? (m & 4095) : ((m - MLAT) & 255);
    const float* pr = P + (size_t)m * 512;
    if (g == 0 || g == 1) {
        const int h = c >> 6, j = c & 63, c1 = 128 * h + j, c2 = c1 + 64;
        float x1 = pr[c1], x2 = pr[c2], o1 = x1, o2 = x2;
        if (lat) { const float cs = o.cosr[t * 64 + j], sn = o.sinr[t * 64 + j]; o1 = x1 * cs - x2 * sn; o2 = x1 * sn + x2 * cs; }
        if (g == 0) { if (lat) { o.RQ[(size_t)m * 512 + c1] = f2bf(o1); o.RQ[(size_t)m * 512 + c2] = f2bf(o2); } }
        else { const int tc = t & 127;
            for (int d = 0; d < 2; ++d) { const float lg = log_sigmoid(o.decay_logit[d * 4 + h]); const float dec = expf(lg * (float)(d == 0 ? 127 - tc : tc)) * RKSCALE;
                bf16_t* dst = o.RKD + (size_t)d * MTOT * 512 + (size_t)m * 512; dst[c1] = f2bf(o1 * dec); dst[c2] = f2bf(o2 * dec); } }
    } else if (g == 2) { o.RV[(size_t)m * 512 + c] = f2bf(pr[c]); o.RV[(size_t)m * 512 + 256 + c] = f2bf(pr[256 + c]);
    } else if (g == 3) { if (lat) { o.RG[(size_t)m * 512 + c] = f2bf(siluf(pr[c])); o.RG[(size_t)m * 512 + 256 + c] = f2bf(siluf(pr[256 + c])); }
    } else if (g == 4 || g == 5) {
        const int hh = c >> 5, j = c & 31, c1 = 64 * hh + j, c2 = c1 + 32;
        float x1 = pr[c1], x2 = pr[c2], o1 = x1, o2 = x2;
        if (lat) { const float cs = o.cosd[t * 32 + j], sn = o.sind[t * 32 + j]; o1 = x1 * cs - x2 * sn; o2 = x1 * sn + x2 * cs; }
        if (g == 4) { if (lat) { o.DQ[(size_t)m * 512 + c1] = f2bf(o1 * QSCALE); o.DQ[(size_t)m * 512 + c2] = f2bf(o2 * QSCALE); } }
        else { const int pos = lat ? 256 + t : t; bf16_t* dst = o.DK + ((size_t)b * KVL + pos) * 512; dst[c1] = f2bf(o1); dst[c2] = f2bf(o2); }
    } else { const int pos = lat ? 256 + t : t; bf16_t* dst = o.DV + ((size_t)b * KVL + pos) * 512; dst[c] = f2bf(pr[c]); dst[256 + c] = f2bf(pr[256 + c]); }
}
__global__ void __launch_bounds__(128) k_ret(const bf16_t* __restrict__ RQ, const bf16_t* __restrict__ RKD, const bf16_t* __restrict__ RV, const bf16_t* __restrict__ RG,
                                            const float* __restrict__ decay_logit, const float* __restrict__ gn_g, float* __restrict__ TMP, bf16_t* __restrict__ YA) {
    __shared__ float qs[128], ks[128], red[8];
    const int b = blockIdx.x >> 2, h = blockIdx.x & 3, e = threadIdx.x;
    for (int d = 0; d < 2; ++d) {
        const float lg = log_sigmoid(decay_logit[d * 4 + h]), gam = expf(lg);
        const float gg = gn_g[d * 512 + h * 128 + e];
        const bf16_t* KD = RKD + (size_t)d * MTOT * 512;
        float S[128];
#pragma unroll
        for (int i = 0; i < 128; ++i) S[i] = 0.f;
        for (int step = 0; step < KVL; ++step) {
            const bool isctx = step < CTXL; const int tt = isctx ? step : step - CTXL; const int L = isctx ? CTXL : SEQ;
            const int t = d == 0 ? tt : L - 1 - tt; const int m = isctx ? MLAT + b * CTXL + t : b * SEQ + t; const int tc = t & 127;
            const float undo = expf(-lg * (float)(d == 0 ? 127 - tc : tc));
            __syncthreads();
            ks[e] = bf2f(KD[(size_t)m * 512 + h * 128 + e]) * undo;
            qs[e] = isctx ? 0.f : bf2f(RQ[(size_t)m * 512 + h * 128 + e]);
            const float v = bf2f(RV[(size_t)m * 512 + h * 128 + e]);
            __syncthreads();
            float oo = 0.f;
#pragma unroll
            for (int i = 0; i < 128; ++i) { S[i] = gam * S[i] + ks[i] * v; oo += qs[i] * S[i]; }
            if (!isctx) {
                const float s1 = wave_sum(oo), s2 = wave_sum(oo * oo);
                if ((e & 63) == 0) { red[(e >> 6) * 2] = s1; red[(e >> 6) * 2 + 1] = s2; }
                __syncthreads();
                const float mu = (red[0] + red[2]) * (1.f / 128.f); const float var = (red[1] + red[3]) * (1.f / 128.f) - mu * mu;
                const float on = (oo - mu) * rsqrtf(var + GN_EPS) * gg;
                const size_t off = (size_t)m * 512 + h * 128 + e;
                if (d == 0) TMP[off] = on; else YA[(size_t)m * 1024 + h * 128 + e] = f2bf(bf2f(RG[off]) * (TMP[off] + on));
            }
        }
    }
}
__global__ void __launch_bounds__(256) k_attn(const bf16_t* __restrict__ DQ, const bf16_t* __restrict__ DK, const bf16_t* __restrict__ DV, const float* __restrict__ subln_g, const float* __restrict__ MISC, bf16_t* __restrict__ YA) {
    const int tid = threadIdx.x, qi = tid >> 2, mp = (tid >> 1) & 1, hf = tid & 1;
    const int h = blockIdx.y, m = blockIdx.x * 64 + qi, b = m >> 12;
    float q[64];
    const bf16_t* qp = DQ + (size_t)m * 512 + h * 128 + mp * 64;
#pragma unroll
    for (int i = 0; i < 64; ++i) q[i] = bf2f(qp[i]);
    float o[64];
#pragma unroll
    for (int i = 0; i < 64; ++i) o[i] = 0.f;
    float mx = -1e30f, l = 0.f;
    const bf16_t* kb = DK + (size_t)b * KVL * 512 + h * 128 + mp * 64;
    const bf16_t* vb = DV + (size_t)b * KVL * 512 + h * 128 + hf * 64;
    for (int j = 0; j < KVL; ++j) {
        const bf16_t* kr = kb + (size_t)j * 512; const bf16_t* vr = vb + (size_t)j * 512;
        float s = 0.f;
#pragma unroll
        for (int i = 0; i < 64; i += 8) { const u32x4 w = *(const u32x4*)(kr + i);
            s += q[i] * __uint_as_float(w.x << 16) + q[i + 1] * __uint_as_float(w.x & 0xffff0000u) + q[i + 2] * __uint_as_float(w.y << 16) + q[i + 3] * __uint_as_float(w.y & 0xffff0000u)
               + q[i + 4] * __uint_as_float(w.z << 16) + q[i + 5] * __uint_as_float(w.z & 0xffff0000u) + q[i + 6] * __uint_as_float(w.w << 16) + q[i + 7] * __uint_as_float(w.w & 0xffff0000u); }
        if (s > mx) { const float a = exp2f(mx - s); l *= a;
#pragma unroll
            for (int i = 0; i < 64; ++i) o[i] *= a;
            mx = s; }
        const float p = exp2f(s - mx); l += p;
#pragma unroll
        for (int i = 0; i < 64; i += 8) { const u32x4 w = *(const u32x4*)(vr + i);
            o[i] += p * __uint_as_float(w.x << 16); o[i + 1] += p * __uint_as_float(w.x & 0xffff0000u); o[i + 2] += p * __uint_as_float(w.y << 16); o[i + 3] += p * __uint_as_float(w.y & 0xffff0000u);
            o[i + 4] += p * __uint_as_float(w.z << 16); o[i + 5] += p * __uint_as_float(w.z & 0xffff0000u); o[i + 6] += p * __uint_as_float(w.w << 16); o[i + 7] += p * __uint_as_float(w.w & 0xffff0000u); }
    }
    const float lam = MISC[0], rl = 1.f / l; float ss = 0.f;
#pragma unroll
    for (int i = 0; i < 64; ++i) { const float mine = o[i] * rl, other = __shfl_xor(mine, 2); const float dd = mp == 0 ? mine - lam * other : other - lam * mine; o[i] = dd; ss += dd * dd; }
    ss += __shfl_xor(ss, 1);
    const float rs = rsqrtf(ss * (1.f / 128.f) + EPS) * (1.f - LAMBDA_INIT);
    if (mp == 0) { bf16_t* yo = YA + (size_t)m * 1024 + 512 + h * 128 + hf * 64; const float* gg = subln_g + h * 128 + hf * 64;
#pragma unroll
        for (int i = 0; i < 64; ++i) yo[i] = f2bf(o[i] * rs * gg[i]); }
}
__global__ void __launch_bounds__(256) k_post_wout(const float* __restrict__ ACC, const float* __restrict__ x, const float* __restrict__ MOD, const float* __restrict__ GAM2, float* __restrict__ OUT, bf16_t* __restrict__ A2, float* __restrict__ rowss) {
    const int lane = threadIdx.x & 63, m = blockIdx.x * 4 + (threadIdx.x >> 6), b = m >> 12; float s = 0.f;
#pragma unroll
    for (int j = 0; j < 4; ++j) { const int k = 4 * lane + 256 * j; const f32x4 a = *(const f32x4*)(ACC + (size_t)m * D + k), xv = *(const f32x4*)(x + (size_t)m * D + k), g1 = *(const f32x4*)(MOD + b * NMOD + 2 * D + k), g2 = *(const f32x4*)(GAM2 + b * D + k);
        const f32x4 x1 = xv + g1 * a; *(f32x4*)(OUT + (size_t)m * D + k) = x1; s += x1.x * x1.x + x1.y * x1.y + x1.z * x1.z + x1.w * x1.w; const f32x4 hq = x1 * g2;
        u32x2 w; w.x = f2bf(hq.x) | ((unsigned)f2bf(hq.y) << 16); w.y = f2bf(hq.z) | ((unsigned)f2bf(hq.w) << 16); *(u32x2*)(A2 + (size_t)m * D + k) = w; }
    s = wave_sum(s); if (lane == 0) rowss[m] = s;
}
__global__ void __launch_bounds__(256) k_post_up(const float* __restrict__ ACC, int n0, int row0, const float* __restrict__ rowss, const float* __restrict__ BIAS2, bf16_t* __restrict__ UH) {
    const int r = blockIdx.x, m = row0 + r, b = m >> 12; const float rstd = rsqrtf(rowss[m] * (1.f / D) + EPS);
    for (int c = threadIdx.x; c < 512; c += 256) UH[(size_t)r * DFF2 + n0 + c] = f2bf(rstd * ACC[(size_t)r * 512 + c] + BIAS2[b * DFF2 + n0 + c]);
}
__global__ void __launch_bounds__(256) k_conv(const bf16_t* __restrict__ UH, int row0, const float* __restrict__ conv_w, const float* __restrict__ conv_b, bf16_t* __restrict__ G) {
    const int r = blockIdx.x, m = row0 + r, t = m & 4095;
    for (int j = threadIdx.x; j < DFF; j += 256) {
        float ca = conv_b[j], cb = conv_b[DFF + j];
        if (t > 0)    { ca += conv_w[j] * bf2f(UH[(size_t)(r - 1) * DFF2 + j]);            cb += conv_w[DFF + j] * bf2f(UH[(size_t)(r - 1) * DFF2 + DFF + j]); }
                      { ca += conv_w[DFF2 + j] * bf2f(UH[(size_t)r * DFF2 + j]);           cb += conv_w[DFF2 + DFF + j] * bf2f(UH[(size_t)r * DFF2 + DFF + j]); }
        if (t < 4095) { ca += conv_w[2 * DFF2 + j] * bf2f(UH[(size_t)(r + 1) * DFF2 + j]); cb += conv_w[2 * DFF2 + DFF + j] * bf2f(UH[(size_t)(r + 1) * DFF2 + DFF + j]); }
        G[(size_t)m * DFF + j] = f2bf(siluf(ca) * cb);
    }
}
__global__ void __launch_bounds__(256) k_post_down(const float* __restrict__ ACC, const float* __restrict__ MOD, const float* __restrict__ final_g, float* __restrict__ OUT) {
    const int lane = threadIdx.x & 63, m = blockIdx.x * 4 + (threadIdx.x >> 6), b = m >> 12; float s = 0.f; f32x4 v[4];
#pragma unroll
    for (int j = 0; j < 4; ++j) { const int k = 4 * lane + 256 * j; const f32x4 a = *(const f32x4*)(ACC + (size_t)m * D + k), x1 = *(const f32x4*)(OUT + (size_t)m * D + k), g2 = *(const f32x4*)(MOD + b * NMOD + 5 * D + k);
        v[j] = x1 + g2 * a; s += v[j].x * v[j].x + v[j].y * v[j].y + v[j].z * v[j].z + v[j].w * v[j].w; }
    const float rstd = rsqrtf(wave_sum(s) * (1.f / D) + EPS);
#pragma unroll
    for (int j = 0; j < 4; ++j) { const int k = 4 * lane + 256 * j; *(f32x4*)(OUT + (size_t)m * D + k) = v[j] * rstd * *(const f32x4*)(final_g + k); }
}
}
namespace pg8 {
#define PG8_LAS __attribute__((address_space(3)))
typedef unsigned short bf16_t;
typedef short bf16x8 __attribute__((ext_vector_type(8)));
typedef float f32x4 __attribute__((ext_vector_type(4)));
typedef unsigned u32x4 __attribute__((ext_vector_type(4)));
constexpr int BM = 256, BK = 64, HALF = 128, HTB = HALF * BK * 2  , STAGE_BYTES = 8 * HTB, NXCD = 8, WGM = 8;

__host__ __device__ __forceinline__ int lds_byte(int r, int c) { const int st = (r >> 4) * 2 + (c >> 5), rr = r & 15, cc = c & 31, ob = rr * 64 + cc * 2; return st * 1024 + (ob ^ (((ob >> 9) & 1) << 5)); }
__host__ __device__ __forceinline__ void stage_rc(int b, int& R, int& C) { const int st = b / 1024, sb = b % 1024, swz = sb ^ (((sb >> 9) & 1) << 5); R = (st >> 1) * 16 + swz / 64; C = (st & 1) * 32 + (swz % 64) / 2; }
__host__ __device__ __forceinline__ int perm32(int rho) { const int n = rho >> 4, i = rho & 15; return 8 * (i >> 2) + 4 * n + (i & 3); }

struct Unit { int pm, pn; };
struct Gemm { const bf16_t* A; const bf16_t* Bt; int M, N, K; };

struct StaticOrder {
    int nM, nN, nwg, G, c;
    __host__ __device__ void init(int M, int N, int G_, int c_) { nM = M / BM; nN = N / BM; nwg = nM * nN; G = G_; c = c_; }
    __host__ __device__ bool next(int i, Unit& u) const {
        const long L = (long)i * G + c; if (L >= nwg) return false;
        int wgid = (int)L; { const int q = nwg / NXCD, r = nwg % NXCD, xcd = wgid % NXCD, off = wgid / NXCD; wgid = (xcd < r ? xcd * (q + 1) : r * (q + 1) + (xcd - r) * q) + off; }
        const int nig = WGM * nN, gid = wgid / nig, fm = gid * WGM, gsz = (nM - fm) < WGM ? (nM - fm) : WGM;
        u.pm = fm + ((wgid % nig) % gsz); u.pn = (wgid % nig) / gsz; return true;
    }
    __device__ __forceinline__ void a_ready(const Unit&) const {}
    __device__ __forceinline__ void done(const Unit&) const {}
};

__device__ __forceinline__ unsigned cvt_pk_bf16(float lo, float hi) { unsigned r; asm volatile("v_cvt_pk_bf16_f32 %0, %1, %2" : "=v"(r) : "v"(lo), "v"(hi)); return r; }
template <class Epi, class Sched, bool ALIGN_EPI = false, bool SP2 = false>
__device__ __forceinline__ void gemm_phase(PG8_LAS unsigned char* lds, const Gemm g, const Sched& S, const Epi& E, int wid_in) {
    const int wid = wid_in, lane = lane_now(), tid = wid * 64 + lane, wr = wid >> 2, wc = wid & 3, fr = lane & 15, fq = lane >> 4;
    const int K = g.K, nt = K / BK;
    unsigned voffA[2], voffB[2];
#pragma unroll
    for (int i = 0; i < 2; ++i) { int R, C; stage_rc(tid * 16 + i * 8192, R, C); const int Rb = Epi::PERM ? ((R & ~31) + perm32(R & 31)) : R;
        voffA[i] = (unsigned)(R * K + C) * 2u; voffB[i] = (unsigned)(Rb * K + C) * 2u; }
    const size_t kstep = (size_t)(BK * 2);
    const size_t hstep = (size_t)HALF * K * 2;
    const size_t tstep = 2 * hstep;
    const unsigned ldsw = (unsigned)wid * 1024u;
    const int aoff = lds_byte(wr * 64 + fr, fq * 8), boff = lds_byte(wc * 32 + fr, fq * 8);
#define PG8_SA(b, h) (((b) * 2 + (h)) * HTB)
#define PG8_SB(b, h) ((4 + (b) * 2 + (h)) * HTB)
#define PG8_STAGE(bufoff, gbase, voff) do { _Pragma("unroll") for (int _i = 0; _i < 2; ++_i) \
        __builtin_amdgcn_global_load_lds((const unsigned*)((const char*)(gbase) + (voff)[_i]), (PG8_LAS unsigned*)(lds + (bufoff) + ldsw + _i * 8192), 16, 0, 0); } while (0)
#define PG8_LDA(dst, b, h) do { _Pragma("unroll") for (int m = 0; m < 4; ++m) _Pragma("unroll") for (int k = 0; k < 2; ++k) dst[m][k] = *(const PG8_LAS bf16x8*)(lds + PG8_SA(b, h) + aoff + m * 2048 + k * 1024); } while (0)
#define PG8_LDB(dst, b, h) do { _Pragma("unroll") for (int n = 0; n < 2; ++n) _Pragma("unroll") for (int k = 0; k < 2; ++k) dst[n][k] = *(const PG8_LAS bf16x8*)(lds + PG8_SB(b, h) + boff + n * 2048 + k * 1024); } while (0)
#define PG8_MMA(ai, bj, At, Bt) do { __builtin_amdgcn_s_setprio(1); _Pragma("unroll") for (int m = 0; m < 4; ++m) _Pragma("unroll") for (int n = 0; n < 2; ++n) _Pragma("unroll") for (int k = 0; k < 2; ++k) \
        acc[ai][bj][m][n] = __builtin_amdgcn_mfma_f32_16x16x32_bf16(Bt[n][k], At[m][k], acc[ai][bj][m][n], 0, 0, 0); __builtin_amdgcn_s_setprio(0); } while (0)
#define PG8_WAIT_V(n) asm volatile("s_waitcnt vmcnt(" #n ")" ::: "memory")
#define PG8_WAIT_L(n) asm volatile("s_waitcnt lgkmcnt(" #n ")" ::: "memory")
#define PG8_BAR __builtin_amdgcn_s_barrier()
#define PG8_SCHED __builtin_amdgcn_sched_barrier(0)
    Unit cur, nxt; int ui = 0;
    if (!S.next(0, cur)) return;
    f32x4 acc[2][2][4][2];
#pragma unroll
    for (int a = 0; a < 2; ++a)
#pragma unroll
        for (int b = 0; b < 2; ++b)
#pragma unroll
            for (int m = 0; m < 4; ++m)
#pragma unroll
                for (int n = 0; n < 2; ++n) acc[a][b][m][n] = (f32x4){0.f, 0.f, 0.f, 0.f};
    bf16x8 At[4][2], B0[2][2], B1[2][2];
    const char* cA = (const char*)g.A + (size_t)cur.pm * tstep; const char* cB = (const char*)g.Bt + (size_t)cur.pn * tstep;
    S.a_ready(cur);
    if constexpr (SP2) {
        PG8_STAGE(PG8_SB(0, 0), cB, voffB); PG8_STAGE(PG8_SB(0, 1), cB + hstep, voffB); PG8_STAGE(PG8_SA(0, 0), cA, voffA); PG8_STAGE(PG8_SA(0, 1), cA + hstep, voffA);
        if (wr == 1) PG8_BAR;
        PG8_WAIT_V(2); PG8_BAR;
        PG8_STAGE(PG8_SB(1, 0), cB + kstep, voffB); PG8_STAGE(PG8_SA(1, 0), cA + kstep, voffA); PG8_STAGE(PG8_SB(1, 1), cB + hstep + kstep, voffB);
        PG8_WAIT_V(6); PG8_BAR;
    } else {
        PG8_STAGE(PG8_SB(0, 0), cB, voffB); PG8_STAGE(PG8_SA(0, 0), cA, voffA); PG8_STAGE(PG8_SB(0, 1), cB + hstep, voffB); PG8_STAGE(PG8_SA(0, 1), cA + hstep, voffA);
        if (wr == 1) PG8_BAR;
        PG8_WAIT_V(4); PG8_BAR;
        PG8_STAGE(PG8_SB(1, 0), cB + kstep, voffB); PG8_STAGE(PG8_SA(1, 0), cA + kstep, voffA); PG8_STAGE(PG8_SB(1, 1), cB + hstep + kstep, voffB);
        PG8_WAIT_V(6); PG8_BAR;
    }
    for (;;) {
        const bool has_next = S.next(ui + 1, nxt);
        const char* nA = has_next ? (const char*)g.A + (size_t)nxt.pm * tstep : cA; const char* nB = has_next ? (const char*)g.Bt + (size_t)nxt.pn * tstep : cB;
        for (int t = 0; t < nt; t += 2) {
            const bool last = (t == nt - 2);
            const char* a1 = cA + (size_t)(t + 1) * kstep;
            const char* a2 = last ? nA : cA + (size_t)(t + 2) * kstep; const char* b2 = last ? nB : cB + (size_t)(t + 2) * kstep;
            const char* a3 = a2 + kstep; const char* b3 = b2 + kstep;
            if (last && has_next) S.a_ready(nxt);
            if constexpr (SP2) {
            PG8_LDB(B0, 0, 0); PG8_LDB(B1, 0, 1); PG8_SCHED; PG8_LDA(At, 0, 0); PG8_STAGE(PG8_SA(1, 1), a1 + hstep, voffA);
            PG8_WAIT_V(8); PG8_WAIT_L(0); PG8_BAR; PG8_MMA(0, 0, At, B0); PG8_MMA(0, 1, At, B1); PG8_BAR; PG8_SCHED;
            PG8_LDA(At, 0, 1); PG8_STAGE(PG8_SB(0, 0), b2, voffB); PG8_STAGE(PG8_SB(0, 1), b2 + hstep, voffB); PG8_STAGE(PG8_SA(0, 0), a2, voffA);
            PG8_WAIT_V(8); PG8_WAIT_L(0); PG8_BAR; PG8_MMA(1, 0, At, B0); PG8_MMA(1, 1, At, B1); PG8_BAR; PG8_SCHED;
            PG8_LDB(B0, 1, 0); PG8_LDB(B1, 1, 1); PG8_SCHED; PG8_LDA(At, 1, 0); PG8_STAGE(PG8_SA(0, 1), a2 + hstep, voffA);
            PG8_WAIT_V(8); PG8_WAIT_L(0); PG8_BAR; PG8_MMA(0, 0, At, B0); PG8_MMA(0, 1, At, B1); PG8_BAR; PG8_SCHED;
            PG8_LDA(At, 1, 1); PG8_STAGE(PG8_SB(1, 0), b3, voffB); PG8_STAGE(PG8_SB(1, 1), b3 + hstep, voffB); PG8_STAGE(PG8_SA(1, 0), a3, voffA);
            PG8_WAIT_V(8); PG8_WAIT_L(0); PG8_BAR; PG8_MMA(1, 0, At, B0); PG8_MMA(1, 1, At, B1); PG8_BAR; PG8_SCHED;
            } else {
            PG8_LDB(B0, 0, 0); PG8_SCHED; PG8_LDA(At, 0, 0); PG8_STAGE(PG8_SA(1, 1), a1 + hstep, voffA);
            PG8_WAIT_L(8); PG8_BAR; PG8_WAIT_L(0); PG8_MMA(0, 0, At, B0); PG8_BAR; PG8_SCHED;
            PG8_LDB(B1, 0, 1); PG8_STAGE(PG8_SB(0, 0), b2, voffB);
            PG8_BAR; PG8_WAIT_L(0); PG8_MMA(0, 1, At, B1); PG8_BAR;
            PG8_LDA(At, 0, 1); PG8_STAGE(PG8_SA(0, 0), a2, voffA);
            PG8_BAR; PG8_WAIT_L(0); PG8_MMA(1, 0, At, B0); PG8_BAR; PG8_SCHED;
            PG8_STAGE(PG8_SB(0, 1), b2 + hstep, voffB);
            PG8_WAIT_V(6); PG8_BAR; PG8_MMA(1, 1, At, B1); PG8_BAR;
            PG8_LDB(B0, 1, 0); PG8_SCHED; PG8_LDA(At, 1, 0); PG8_STAGE(PG8_SA(0, 1), a2 + hstep, voffA);
            PG8_WAIT_L(8); PG8_BAR; PG8_WAIT_L(0); PG8_MMA(0, 0, At, B0); PG8_BAR; PG8_SCHED;
            PG8_LDB(B1, 1, 1); PG8_STAGE(PG8_SB(1, 0), b3, voffB);
            PG8_BAR; PG8_WAIT_L(0); PG8_MMA(0, 1, At, B1); PG8_BAR;
            PG8_LDA(At, 1, 1); PG8_STAGE(PG8_SA(1, 0), a3, voffA);
            PG8_BAR; PG8_WAIT_L(0); PG8_MMA(1, 0, At, B0); PG8_BAR; PG8_SCHED;
            PG8_STAGE(PG8_SB(1, 1), b3 + hstep, voffB);
            PG8_WAIT_V(6); PG8_BAR; PG8_MMA(1, 1, At, B1); PG8_BAR;
            }
        }
        if constexpr (ALIGN_EPI) { if (wr == 0) PG8_BAR; }
        if constexpr (!Epi::AFTER_DRAIN) { E(acc, cur, wr, wc, fr, fq); S.done(cur); }
        if (!has_next) break;
#pragma unroll
        for (int a = 0; a < 2; ++a)
#pragma unroll
            for (int b = 0; b < 2; ++b)
#pragma unroll
                for (int m = 0; m < 4; ++m)
#pragma unroll
                    for (int n = 0; n < 2; ++n) acc[a][b][m][n] = (f32x4){0.f, 0.f, 0.f, 0.f};
        cur = nxt; cA = nA; cB = nB; ++ui;
        if constexpr (ALIGN_EPI) { if (wr == 1) PG8_BAR; }
    }
    PG8_WAIT_V(0);
    if constexpr (!ALIGN_EPI) { if (wr == 0) PG8_BAR; }
    PG8_BAR;
    if constexpr (Epi::AFTER_DRAIN) { E.fused(acc, cur, wr, wc, fr, fq, lds, wid, lane); S.done(cur); }
#undef PG8_SA
#undef PG8_SB
#undef PG8_STAGE
#undef PG8_LDA
#undef PG8_LDB
#undef PG8_MMA
#undef PG8_WAIT_V
#undef PG8_WAIT_L
#undef PG8_BAR
#undef PG8_SCHED
}
}
namespace da {
using bf16x8 = __attribute__((ext_vector_type(8))) short;
using s16x4  = __attribute__((ext_vector_type(4))) short;
using f32x16 = __attribute__((ext_vector_type(16))) float;
constexpr int KVBLK = 64, LDK = 512, NT = KVL / KVBLK;
constexpr int SHM_V = KVBLK * 128 * 2, SHM_K = KVBLK * 128 * 2, SHM_ATTN = 2 * SHM_V + 2 * SHM_K + 8 * 64 * 4;
constexpr float THRL = 8.f;
static_assert(NT % 2 == 0, "even tile count");
#define DA_KSWZ(row, colB) ((row) * 256 + ((colB) ^ (((row) & 7) << 4)))
#define DA_SBAR() __builtin_amdgcn_sched_barrier(0)
__device__ __forceinline__ int crow(int r, int hi) { return (r & 3) + 8 * (r >> 2) + 4 * hi; }
__device__ __forceinline__ unsigned cvtpk(float lo, float hi) { unsigned r; asm volatile("v_cvt_pk_bf16_f32 %0, %1, %2" : "=v"(r) : "v"(lo), "v"(hi)); return r; }

__device__ __forceinline__ void partialSM(f32x16& p0, f32x16& p1, float& m_reg, float& mn, float& alpha) {
  float pmax = p0[0];
#pragma unroll
  for (int r = 1; r < 16; ++r) pmax = fmaxf(pmax, p0[r]);
#pragma unroll
  for (int r = 0; r < 16; ++r) pmax = fmaxf(pmax, p1[r]);
  { auto rr = __builtin_amdgcn_permlane32_swap(__float_as_uint(pmax), __float_as_uint(pmax), false, false);
    pmax = fmaxf(__uint_as_float(rr[0]), __uint_as_float(rr[1])); }
  if (__builtin_expect(__all(pmax - m_reg <= THRL), 1)) { mn = m_reg; alpha = 1.f; }
  else { mn = fmaxf(m_reg, pmax); alpha = __builtin_amdgcn_exp2f(m_reg - mn); m_reg = mn; }
#pragma unroll
  for (int r = 0; r < 16; ++r) { p0[r] = p0[r] - mn; p1[r] = p1[r] - mn; }
#pragma unroll
  for (int r = 0; r < 16; ++r) p0[r] = __builtin_amdgcn_exp2f(p0[r]);
}
__device__ __forceinline__ void finishSM(f32x16& p0, f32x16& p1, float alpha, float& l_reg, bf16x8& pa0, bf16x8& pa1, bf16x8& pa2, bf16x8& pa3) {
#pragma unroll
  for (int r = 0; r < 16; ++r) p1[r] = __builtin_amdgcn_exp2f(p1[r]);
  float ps = 0;
#pragma unroll
  for (int r = 0; r < 16; ++r) ps += p0[r];
#pragma unroll
  for (int r = 0; r < 16; ++r) ps += p1[r];
  { auto rr = __builtin_amdgcn_permlane32_swap(__float_as_uint(ps), __float_as_uint(ps), false, false);
    ps = __uint_as_float(rr[0]) + __uint_as_float(rr[1]); }
  l_reg = l_reg * alpha + ps;
#define DA_PK4(P, BASE, OUT) do { unsigned a0 = cvtpk(P[BASE + 0], P[BASE + 1]), a1 = cvtpk(P[BASE + 2], P[BASE + 3]);   \
    unsigned b0 = cvtpk(P[BASE + 4], P[BASE + 5]), b1 = cvtpk(P[BASE + 6], P[BASE + 7]);                              \
    auto r0 = __builtin_amdgcn_permlane32_swap(a0, b0, false, false); auto r1 = __builtin_amdgcn_permlane32_swap(a1, b1, false, false); \
    u32x4 w = {r0[0], r1[0], r0[1], r1[1]}; OUT = *reinterpret_cast<bf16x8*>(&w); } while (0)
  DA_PK4(p0, 0, pa0); DA_PK4(p0, 8, pa1); DA_PK4(p1, 0, pa2); DA_PK4(p1, 8, pa3);
#undef DA_PK4
}
__device__ __forceinline__ void qkt(f32x16& p0, f32x16& p1, const char* Ks, const bf16x8* qr, int r32, int hi, int mp) {
  p0 = f32x16{}; p1 = f32x16{};
#pragma unroll
  for (int d0 = 0; d0 < 4; ++d0) { const int cb = (mp * 64 + d0 * 16 + hi * 8) * 2;
    bf16x8 b0 = *reinterpret_cast<const bf16x8*>(Ks + DA_KSWZ(r32, cb));
    bf16x8 b1 = *reinterpret_cast<const bf16x8*>(Ks + DA_KSWZ(32 + r32, cb));
    p0 = __builtin_amdgcn_mfma_f32_32x32x16_bf16(b0, qr[d0], p0, 0, 0, 0);
    p1 = __builtin_amdgcn_mfma_f32_32x32x16_bf16(b1, qr[d0], p1, 0, 0, 0); }
}
__device__ __forceinline__ int v_st(int k, int c) { const int kk = (k & ~0xC) | ((k & 4) << 1) | ((k & 8) >> 1); return ((kk >> 3) * 4 + (c >> 5)) * 512 + ((kk & 7) * 32 + (c & 31)) * 2; }
__device__ __forceinline__ int v_rd_base(int lane) { return ((lane & 3) << 3) | (((lane >> 2) & 3) << 6) | (((lane >> 4) & 1) << 5) | (((lane >> 5) & 1) << 8); }
constexpr int v_rd_off(int d0, int ks, int half) { return d0 * 512 + ks * 4096 + half * 2048; }
template <int OFF> __device__ __forceinline__ s16x4 tr_read(int vb) {
  s16x4 r; asm volatile("ds_read_b64_tr_b16 %0, %1 offset:%2" : "=&v"(r) : "v"(vb), "i"(OFF) : "memory"); return r;
}
template <int D0> __device__ __forceinline__ void pv_one(f32x16& od, int vb, bf16x8 pa0, bf16x8 pa1, bf16x8 pa2, bf16x8 pa3) {
  const s16x4 l0 = tr_read<v_rd_off(D0, 0, 0)>(vb), h0 = tr_read<v_rd_off(D0, 0, 1)>(vb), l1 = tr_read<v_rd_off(D0, 1, 0)>(vb), h1 = tr_read<v_rd_off(D0, 1, 1)>(vb);
  const s16x4 l2 = tr_read<v_rd_off(D0, 2, 0)>(vb), h2 = tr_read<v_rd_off(D0, 2, 1)>(vb), l3 = tr_read<v_rd_off(D0, 3, 0)>(vb), h3 = tr_read<v_rd_off(D0, 3, 1)>(vb);
  asm volatile("s_waitcnt lgkmcnt(0)" ::: "memory"); DA_SBAR();
#define DA_PK(L, H) (bf16x8){L[0], L[1], L[2], L[3], H[0], H[1], H[2], H[3]}
  od = __builtin_amdgcn_mfma_f32_32x32x16_bf16(pa0, DA_PK(l0, h0), od, 0, 0, 0);
  od = __builtin_amdgcn_mfma_f32_32x32x16_bf16(pa1, DA_PK(l1, h1), od, 0, 0, 0);
  od = __builtin_amdgcn_mfma_f32_32x32x16_bf16(pa2, DA_PK(l2, h2), od, 0, 0, 0);
  od = __builtin_amdgcn_mfma_f32_32x32x16_bf16(pa3, DA_PK(l3, h3), od, 0, 0, 0);
#undef DA_PK
}
__device__ __forceinline__ void pv_d0(f32x16* o, int vb, bf16x8 pa0, bf16x8 pa1, bf16x8 pa2, bf16x8 pa3) {
  pv_one<0>(o[0], vb, pa0, pa1, pa2, pa3); pv_one<1>(o[1], vb, pa0, pa1, pa2, pa3); pv_one<2>(o[2], vb, pa0, pa1, pa2, pa3); pv_one<3>(o[3], vb, pa0, pa1, pa2, pa3);
}

__device__ __forceinline__ void attn_unit(const bf16_t* __restrict__ Qb, const bf16_t* __restrict__ Kh, const bf16_t* __restrict__ Vh, bf16_t* __restrict__ Yb,
                                          const float* __restrict__ gsub, float lam, char* lds, int wid) {
  const int lane = lane_now(), tid = wid * 64 + lane, r32 = lane & 31, hi = lane >> 5, mp = wid >> 2, wq = wid & 3;
  char* V_lds = lds; char* K_lds = lds + 2 * SHM_V;
  float* wsf = (float*)(lds + 2 * SHM_V + 2 * SHM_K) + wid * 64; float* li_l = wsf; float* al_l = wsf + 32;
  float m_reg = -1e30f, l_reg = 0; f32x16 o[4] = {}; bf16x8 qr[4];
  const bf16_t* Qw = Qb + (long)(wq * 32 + r32) * 512 + mp * 64 + hi * 8;
#pragma unroll
  for (int d0 = 0; d0 < 4; ++d0) qr[d0] = *reinterpret_cast<const bf16x8*>(Qw + d0 * 16);
  const int sr = tid >> 4, sc = (tid & 15) * 8, vst0 = v_st(sr, sc), vst1 = v_st(32 + sr, sc);
  const int vb0 = (int)(uintptr_t)V_lds + v_rd_base(lane);
  struct { bf16x8 vs0, vs1, ks0, ks1; } sr_[2];
#define SLOAD(i, k0) do { sr_[i].vs0 = *reinterpret_cast<const bf16x8*>(&Vh[(long)((k0) + sr) * LDK + sc]); sr_[i].vs1 = *reinterpret_cast<const bf16x8*>(&Vh[(long)((k0) + 32 + sr) * LDK + sc]); \
    sr_[i].ks0 = *reinterpret_cast<const bf16x8*>(&Kh[(long)((k0) + sr) * LDK + sc]); sr_[i].ks1 = *reinterpret_cast<const bf16x8*>(&Kh[(long)((k0) + 32 + sr) * LDK + sc]); } while (0)
#define SWRITE(b, i) do { *(bf16x8*)(V_lds + (b) * SHM_V + vst0) = sr_[i].vs0; *(bf16x8*)(V_lds + (b) * SHM_V + vst1) = sr_[i].vs1; const int kc = sc * 2; \
    *(bf16x8*)(K_lds + (b) * SHM_K + DA_KSWZ(sr, kc)) = sr_[i].ks0; *(bf16x8*)(K_lds + (b) * SHM_K + DA_KSWZ(32 + sr, kc)) = sr_[i].ks1; } while (0)
#define SWAIT() asm volatile("s_waitcnt vmcnt(4)" ::: "memory")
#define RESC(a) do { if (__any((a) < 1.f)) { if (hi == 0) al_l[r32] = (a); asm volatile("s_waitcnt lgkmcnt(0)" ::: "memory"); \
    _Pragma("unroll") for (int d = 0; d < 4; ++d) _Pragma("unroll") for (int r = 0; r < 16; ++r) o[d][r] *= al_l[crow(r, hi)]; } } while (0)
  f32x16 pA0, pA1, pB0, pB1; float mnA, mnB, alA, alB; bf16x8 pa0, pa1, pa2, pa3;
  constexpr int SE = 0, SO = 1;
  SLOAD(SE, 0); asm volatile("s_waitcnt vmcnt(0)" ::: "memory"); SWRITE(0, SE); __syncthreads();
  qkt(pA0, pA1, K_lds, qr, r32, hi, mp); partialSM(pA0, pA1, m_reg, mnA, alA);
  SLOAD(SO, KVBLK); SLOAD(SE, 2 * KVBLK);
  SWAIT(); SWRITE(1, SO); __syncthreads();
  for (int j = 1; j + 1 < NT; j += 2) {
    DA_SBAR(); qkt(pB0, pB1, K_lds + SHM_K, qr, r32, hi, mp);
    finishSM(pA0, pA1, alA, l_reg, pa0, pa1, pa2, pa3); DA_SBAR();
    SLOAD(SO, (j + 2) * KVBLK); DA_SBAR();
    pv_d0(o, vb0, pa0, pa1, pa2, pa3); partialSM(pB0, pB1, m_reg, mnB, alB);
    __syncthreads(); SWAIT(); SWRITE(0, SE);
    RESC(alB); __syncthreads();
    DA_SBAR(); qkt(pA0, pA1, K_lds, qr, r32, hi, mp);
    finishSM(pB0, pB1, alB, l_reg, pa0, pa1, pa2, pa3); DA_SBAR();
    if (j + 3 < NT) SLOAD(SE, (j + 3) * KVBLK); DA_SBAR();
    pv_d0(o, vb0 + SHM_V, pa0, pa1, pa2, pa3); partialSM(pA0, pA1, m_reg, mnA, alA);
    __syncthreads(); SWAIT(); SWRITE(1, SO);
    RESC(alA); __syncthreads();
  }
  DA_SBAR(); qkt(pB0, pB1, K_lds + SHM_K, qr, r32, hi, mp);
  finishSM(pA0, pA1, alA, l_reg, pa0, pa1, pa2, pa3); DA_SBAR();
  pv_d0(o, vb0, pa0, pa1, pa2, pa3); partialSM(pB0, pB1, m_reg, mnB, alB);
  __syncthreads(); RESC(alB);
  finishSM(pB0, pB1, alB, l_reg, pa0, pa1, pa2, pa3); DA_SBAR();
  pv_d0(o, vb0 + SHM_V, pa0, pa1, pa2, pa3);
  if (hi == 0) li_l[r32] = l_reg; asm volatile("s_waitcnt lgkmcnt(0)" ::: "memory");
  float rli[16];
#pragma unroll
  for (int r = 0; r < 16; ++r) rli[r] = __builtin_amdgcn_rcpf(li_l[crow(r, hi)]);
  __syncthreads();
  float* xch = (float*)lds;
  if (mp == 1) {
#pragma unroll
    for (int d0 = 0; d0 < 4; ++d0)
#pragma unroll
      for (int r = 0; r < 16; ++r) xch[((wq * 4 + d0) * 16 + r) * 64 + lane] = o[d0][r] * rli[r];
  }
  __syncthreads();
  if (mp == 0) {
    float ssq[16];
#pragma unroll
    for (int r = 0; r < 16; ++r) ssq[r] = 0.f;
#pragma unroll
    for (int d0 = 0; d0 < 4; ++d0)
#pragma unroll
      for (int r = 0; r < 16; ++r) { const float o1 = xch[((wq * 4 + d0) * 16 + r) * 64 + lane]; const float dd = o[d0][r] * rli[r] - lam * o1; o[d0][r] = dd; ssq[r] += dd * dd; }
#pragma unroll
    for (int r = 0; r < 16; ++r) {
#pragma unroll
      for (int off = 1; off < 32; off <<= 1) ssq[r] += __shfl_xor(ssq[r], off);
    }
    float gv[4];
#pragma unroll
    for (int d0 = 0; d0 < 4; ++d0) gv[d0] = gsub[d0 * 32 + r32] * (1.f - LAMBDA_INIT);
#pragma unroll
    for (int r = 0; r < 16; ++r) { const float rs = rsqrtf(ssq[r] * (1.f / 128.f) + EPS); bf16_t* yr = Yb + (long)(wq * 32 + crow(r, hi)) * 1024 + r32;
#pragma unroll
      for (int d0 = 0; d0 < 4; ++d0) yr[d0 * 32] = f2bf(o[d0][r] * rs * gv[d0]); }
  }
  __syncthreads();
#undef SLOAD
#undef SWRITE
#undef SWAIT
#undef RESC
}
#undef DA_KSWZ
#undef DA_SBAR
}
namespace rt {
#define RLAS __attribute__((address_space(3)))
using bf16x8 = __attribute__((ext_vector_type(8))) short;
using s16x4  = __attribute__((ext_vector_type(4))) short;
using f32x16 = __attribute__((ext_vector_type(16))) float;
typedef short v4i16_t __attribute__((ext_vector_type(4)));
typedef float f32x2 __attribute__((ext_vector_type(2)));
constexpr int TILEB = 32768, NSEG = 8, SEGC = 4, NSLOT = 8;
constexpr int T_Q = 0, T_K = TILEB, T_V = 2 * TILEB, T_S = 3 * TILEB;
constexpr size_t E_UNIT = 32 * 512;

__device__ __forceinline__ int crow(int r, int hi) { return (r & 3) + 8 * (r >> 2) + 4 * hi; }
__device__ __forceinline__ int toff(int row, int ch) { return 256 * row + 16 * (ch ^ (((row & 3) << 2) | ((row >> 2) & 3))); }
__device__ __forceinline__ void stage_tile(RLAS char* T, const bf16_t* __restrict__ g, int tid) {
    u32x4 v[4];
#pragma unroll
    for (int i = 0; i < 4; ++i) { const int idx = tid + 512 * i, row = idx >> 4, ch = idx & 15; v[i] = *(const u32x4*)(g + (size_t)row * 512 + ch * 8); }
#pragma unroll
    for (int i = 0; i < 4; ++i) { const int idx = tid + 512 * i, row = idx >> 4, ch = idx & 15; *(RLAS u32x4*)(T + toff(row, ch)) = v[i]; }
}
__device__ __forceinline__ bf16x8 rowfrag(const RLAS char* T, int row, int ch) { return *(const RLAS bf16x8*)(T + toff(row, ch)); }
__device__ __forceinline__ s16x4 trd(const RLAS char* p) { return __builtin_bit_cast(s16x4, __builtin_amdgcn_ds_read_tr16_b64_v4i16((RLAS v4i16_t*)p)); }
__device__ __forceinline__ bf16x8 trfrag(const RLAS char* T, int rbase, int cbase, int lane) {
    const int g = lane >> 4, ii = lane & 15, q = ii >> 2, p = ii & 3, row = rbase + 8 * (g >> 1) + q, chunk = ((cbase + 16 * (g & 1)) >> 3) + (p >> 1);
    const s16x4 lo = trd(T + toff(row, chunk) + 8 * (p & 1)), hi = trd(T + toff(row + 4, chunk) + 8 * (p & 1));
    return (bf16x8){lo[0], lo[1], lo[2], lo[3], hi[0], hi[1], hi[2], hi[3]};
}
__device__ __forceinline__ void s_update(f32x16 (&S)[2], const RLAS char* Tk, const RLAS char* Tv, float cdec, int wa, int wb, int lane) {
#pragma unroll
    for (int n = 0; n < 2; ++n)
#pragma unroll
        for (int r = 0; r < 16; ++r) S[n][r] *= cdec;
#pragma unroll 2
    for (int ks = 0; ks < 8; ++ks) { const bf16x8 a = trfrag(Tk, 16 * ks, 32 * wa, lane);
#pragma unroll
        for (int n = 0; n < 2; ++n) { const bf16x8 b = trfrag(Tv, 16 * ks, 64 * wb + 32 * n, lane); S[n] = __builtin_amdgcn_mfma_f32_32x32x16_bf16(a, b, S[n], 0, 0, 0); } }
}
__device__ __forceinline__ int chunk_row(int b, int c) { return c < 0 ? MLAT + b * CTXL + (c + 2) * 128 : b * SEQ + c * 128; }
__device__ __forceinline__ int slot_chunk(int slot, int d, int k) {
    if (slot == 0) return d == 0 ? -2 + k : -1 - k;
    const int p = slot - 1, sg = d == 0 ? p : NSEG - 1 - p; return d == 0 ? sg * SEGC + k : sg * SEGC + (SEGC - 1 - k);
}
__device__ __forceinline__ void r1_unit(int b, int h, int d, int slot, const bf16_t* __restrict__ RKD, const bf16_t* __restrict__ RV, const float* __restrict__ decay_logit, float* __restrict__ E, RLAS char* lds, int wid) {
    const int lane = lane_now(), tid = wid * 64 + lane, wa = wid >> 1, wb = wid & 1;
    const float cdec = __builtin_amdgcn_exp2f(128.f * log_sigmoid(decay_logit[d * 4 + h]) * 1.4426950408889634f);
    f32x16 S[2] = {};
    const int nch = slot == 0 ? 2 : SEGC;
    for (int k = 0; k < nch; ++k) {
        const int m0 = chunk_row(b, slot_chunk(slot, d, k));
        __syncthreads();
        stage_tile(lds + T_K, RKD + (size_t)d * MTOT * 512 + (size_t)m0 * 512 + h * 128, tid);
        stage_tile(lds + T_V, RV + (size_t)m0 * 512 + h * 128, tid);
        __syncthreads();
        s_update(S, lds + T_K, lds + T_V, cdec, wa, wb, lane);
    }
    float* e = E + ((size_t)((b * 4 + h) * 2 + d) * NSLOT + slot) * E_UNIT + tid;
#pragma unroll
    for (int n = 0; n < 2; ++n)
#pragma unroll
        for (int r = 0; r < 16; ++r) e[(n * 16 + r) * 512] = S[n][r];
}
__device__ __forceinline__ void r3_unit(int b, int h, int sg, const bf16_t* __restrict__ RQ, const bf16_t* __restrict__ RKD, const bf16_t* __restrict__ RV, const bf16_t* __restrict__ RG,
                                        const float* __restrict__ decay_logit, const float* __restrict__ gn_g, const float* __restrict__ E, float* __restrict__ TMP, bf16_t* __restrict__ YA, RLAS char* lds, int wid) {
    const int lane = lane_now(), tid = wid * 64 + lane, wa = wid >> 1, wb = wid & 1, r32 = lane & 31, hi = lane >> 5;
    RLAS char* Tq = lds + T_Q; RLAS char* Tk = lds + T_K; RLAS char* Tv = lds + T_V; RLAS char* Ts = lds + T_S; RLAS float* stg = (RLAS float*)lds;
#pragma unroll 1
    for (int d = 0; d < 2; ++d) {
        const float l2g = log_sigmoid(decay_logit[d * 4 + h]) * 1.4426950408889634f;
        const float cdec = __builtin_amdgcn_exp2f(128.f * l2g), cseg = __builtin_amdgcn_exp2f(128.f * SEGC * l2g);
        const int p = d == 0 ? sg : NSEG - 1 - sg;
        const float* Eb = E + (size_t)((b * 4 + h) * 2 + d) * NSLOT * E_UNIT + tid;
        f32x16 S[2];
#pragma unroll
        for (int n = 0; n < 2; ++n)
#pragma unroll
            for (int r = 0; r < 16; ++r) S[n][r] = Eb[(n * 16 + r) * 512];
        for (int pp = 0; pp < p; ++pp) { const float* Ep = Eb + (size_t)(1 + pp) * E_UNIT;
#pragma unroll
            for (int n = 0; n < 2; ++n)
#pragma unroll
                for (int r = 0; r < 16; ++r) S[n][r] = S[n][r] * cseg + Ep[(n * 16 + r) * 512]; }
        const f32x2 gng = *(const f32x2*)(gn_g + d * 512 + h * 128 + 2 * lane);
        __syncthreads();
#define WRITE_ST() do { _Pragma("unroll") for (int n = 0; n < 2; ++n) { const int e = 64 * wb + 32 * n + r32; _Pragma("unroll") for (int g4 = 0; g4 < 4; ++g4) { \
            u32x2 w; w.x = pg8::cvt_pk_bf16(S[n][4 * g4], S[n][4 * g4 + 1]); w.y = pg8::cvt_pk_bf16(S[n][4 * g4 + 2], S[n][4 * g4 + 3]); \
            *(RLAS u32x2*)(Ts + toff(e, 4 * wa + g4) + 8 * hi) = w; } } } while (0)
        WRITE_ST();
        for (int k = 0; k < SEGC; ++k) {
            const int c = d == 0 ? sg * SEGC + k : sg * SEGC + (SEGC - 1 - k), m0 = b * SEQ + c * 128;
            __syncthreads();
            stage_tile(Tq, RQ + (size_t)m0 * 512 + h * 128, tid);
            stage_tile(Tk, RKD + (size_t)d * MTOT * 512 + (size_t)m0 * 512 + h * 128, tid);
            stage_tile(Tv, RV + (size_t)m0 * 512 + h * 128, tid);
            __syncthreads();
            f32x16 sc[2] = {};
#pragma unroll 2
            for (int ks = 0; ks < 8; ++ks) { const bf16x8 a = rowfrag(Tk, 32 * wa + r32, 2 * ks + hi);
#pragma unroll
                for (int n = 0; n < 2; ++n) { const bf16x8 bq = rowfrag(Tq, 64 * wb + 32 * n + r32, 2 * ks + hi); sc[n] = __builtin_amdgcn_mfma_f32_32x32x16_bf16(a, bq, sc[n], 0, 0, 0); } }
            s_update(S, Tk, Tv, cdec, wa, wb, lane);
            __syncthreads();
#pragma unroll
            for (int n = 0; n < 2; ++n) { const int i = 64 * wb + 32 * n + r32; const float rf = __builtin_amdgcn_exp2f(l2g * (float)(d == 0 ? i - 127 : -i));
#pragma unroll
                for (int g4 = 0; g4 < 4; ++g4) { float pv[4];
#pragma unroll
                    for (int q = 0; q < 4; ++q) { const int j = 32 * wa + 8 * g4 + 4 * hi + q; const bool keep = d == 0 ? (i >= j) : (j >= i); pv[q] = keep ? sc[n][4 * g4 + q] * rf : 0.f; }
                    u32x2 w; w.x = pg8::cvt_pk_bf16(pv[0], pv[1]); w.y = pg8::cvt_pk_bf16(pv[2], pv[3]);
                    *(RLAS u32x2*)(Tk + toff(i, 4 * wa + g4) + 8 * hi) = w; } }
            __syncthreads();
            f32x16 oP[2] = {};
#pragma unroll 2
            for (int ks = 0; ks < 8; ++ks) { const bf16x8 aq = rowfrag(Tq, 32 * wa + r32, 2 * ks + hi);
#pragma unroll
                for (int n = 0; n < 2; ++n) { const bf16x8 bs = rowfrag(Ts, 64 * wb + 32 * n + r32, 2 * ks + hi); oP[n] = __builtin_amdgcn_mfma_f32_32x32x16_bf16(aq, bs, oP[n], 0, 0, 0); } }
#pragma unroll
            for (int r = 0; r < 16; ++r) { const int i = 32 * wa + crow(r, hi); const float qd = __builtin_amdgcn_exp2f(l2g * (float)(d == 0 ? i + 1 : 128 - i)); oP[0][r] *= qd; oP[1][r] *= qd; }
#pragma unroll 2
            for (int ks = 0; ks < 8; ++ks) { const bf16x8 ap = rowfrag(Tk, 32 * wa + r32, 2 * ks + hi);
#pragma unroll
                for (int n = 0; n < 2; ++n) { const bf16x8 bv = trfrag(Tv, 16 * ks, 64 * wb + 32 * n, lane); oP[n] = __builtin_amdgcn_mfma_f32_32x32x16_bf16(ap, bv, oP[n], 0, 0, 0); } }
            __syncthreads();
#pragma unroll
            for (int n = 0; n < 2; ++n)
#pragma unroll
                for (int r = 0; r < 16; ++r) stg[(32 * wa + crow(r, hi)) * 128 + 64 * wb + 32 * n + r32] = oP[n][r];
            WRITE_ST();
            __syncthreads();
#pragma unroll 4
            for (int rr = 0; rr < 16; ++rr) { const int i = 16 * wid + rr; const size_t m = (size_t)m0 + i;
                const f32x2 v = *(const RLAS f32x2*)(stg + i * 128 + 2 * lane);
                const float s1 = wave_sum(v.x + v.y), s2 = wave_sum(v.x * v.x + v.y * v.y);
                const float mu = s1 * (1.f / 128.f), var = s2 * (1.f / 128.f) - mu * mu, rs = rsqrtf(var + GN_EPS);
                const f32x2 on = (v - mu) * rs * gng;
                float* tp = TMP + m * 512 + h * 128 + 2 * lane;
                if (d == 0) *(f32x2*)tp = on;
                else { const f32x2 t = *(const f32x2*)tp; const unsigned rgw = *(const unsigned*)(RG + m * 512 + h * 128 + 2 * lane);
                    const float y0 = __uint_as_float(rgw << 16) * (t.x + on.x), y1 = __uint_as_float(rgw & 0xffff0000u) * (t.y + on.y);
                    *(unsigned*)(YA + m * 1024 + h * 128 + 2 * lane) = pg8::cvt_pk_bf16(y0, y1); } }
        }
        asm volatile("s_waitcnt vmcnt(0)" ::: "memory");
        __syncthreads();
#undef WRITE_ST
    }
}
#undef RLAS
}
#include <hip/hip_cooperative_groups.h>
namespace cg = cooperative_groups;
namespace mk {
#define LAS __attribute__((address_space(3)))
using pg8::Unit; using pg8::Gemm; using pg8::StaticOrder; using pg8::cvt_pk_bf16;
constexpr int NTHR = 512, NWAVES = 8, LDS_BYTES = 147456;
constexpr float LOG2E = 1.4426950408889634f;

struct Args { const float* in[19]; float* out; unsigned char* ws; int ph_lo, ph_hi; };

__device__ __forceinline__ void store8(bf16_t* p, f32x4 a, f32x4 b) {
    u32x4 w; w.x = cvt_pk_bf16(a[0], a[1]); w.y = cvt_pk_bf16(a[2], a[3]); w.z = cvt_pk_bf16(b[0], b[1]); w.w = cvt_pk_bf16(b[2], b[3]); *(u32x4*)p = w;
}
__device__ __forceinline__ f32x4 silu4(f32x4 v) { f32x4 r; r.x = siluf(v.x); r.y = siluf(v.y); r.z = siluf(v.z); r.w = siluf(v.w); return r; }

__device__ __forceinline__ int colmap_in(int np) {
    const int pn = np >> 8, tl = np & 255, bj = tl >> 7, u = tl & 127, g = pn >> 1, sub = pn & 1;
    if (g == 0 || g == 1) return 512 * g + 256 * sub + 128 * (u >> 6) + 64 * bj + (u & 63);
    if (g == 4 || g == 5) return 512 * g + 256 * sub + 64 * (u >> 5) + 32 * bj + (u & 31);
    return np;
}
__device__ __forceinline__ int colmap_up(int np) { const int pn = np >> 8, tl = np & 255, bj = tl >> 7, u = tl & 127; return bj * DFF + 128 * pn + u; }

__device__ __forceinline__ unsigned pk2(float lo, float hi) { return (unsigned)f2bf(lo) | ((unsigned)f2bf(hi) << 16); }
__device__ __forceinline__ void transpose_item(const float* __restrict__ W, int K, int N, bf16_t* __restrict__ WT, int k0, int nrow0, int src0, LAS float* scr, int lane) {
#pragma unroll 8
    for (int i = 0; i < 32; ++i) { const int kk = 2 * i + (lane >> 5); scr[kk * 33 + (lane & 31)] = W[(size_t)(k0 + kk) * N + src0 + (lane & 31)]; }
    asm volatile("s_waitcnt lgkmcnt(0)" ::: "memory");
    const int c = lane & 7;
#pragma unroll
    for (int j = 0; j < 4; ++j) { const int n = (lane >> 3) + 8 * j; const LAS float* s = scr + (8 * c) * 33 + n;
        u32x4 o; o.x = pk2(s[0 * 33], s[1 * 33]); o.y = pk2(s[2 * 33], s[3 * 33]); o.z = pk2(s[4 * 33], s[5 * 33]); o.w = pk2(s[6 * 33], s[7 * 33]);
        *(u32x4*)(WT + (size_t)(nrow0 + n) * K + k0 + 8 * c) = o; }
    asm volatile("s_waitcnt lgkmcnt(0)" ::: "memory");
}

struct EpiWin {
    static constexpr bool PERM = true, AFTER_DRAIN = false;
    bf16_t *RQ, *RKD, *RV, *RG, *DQ, *DK, *DV; const float *cosr, *sinr, *cosd, *sind, *decay_logit;
    __device__ __forceinline__ void operator()(const f32x4 (&acc)[2][2][4][2], const Unit& u, int wr, int wc, int fr, int fq) const {
        const int g = u.pn >> 1, sub = u.pn & 1; const bool lat = u.pm < MLAT / 256;
        const int row0 = u.pm * 256 + wr * 64 + fr, ub = 32 * wc + 8 * fq;
        if (!lat && (g == 0 || g == 3 || g == 4)) return;
        if (g == 0 || g == 1 || g == 4 || g == 5) {
            const bool ret = g < 2;
            const int col1 = ret ? 256 * sub + 128 * (wc >> 1) + (ub & 63) : 256 * sub + 64 * wc + 8 * fq;
            const int col2 = col1 + (ret ? 64 : 32);
            const float* ct = ret ? cosr + (ub & 63) : cosd + 8 * fq; const float* st = ret ? sinr + (ub & 63) : sind + 8 * fq; const int tstr = ret ? 64 : 32;
            float l2g0 = 0.f, l2g1 = 0.f;
            if (g == 1) { const int h = 2 * sub + (wc >> 1); l2g0 = log_sigmoid(decay_logit[h]) * LOG2E; l2g1 = log_sigmoid(decay_logit[4 + h]) * LOG2E; }
#pragma unroll
            for (int ai = 0; ai < 2; ++ai)
#pragma unroll
                for (int m = 0; m < 4; ++m) {
                    const int row = row0 + 128 * ai + 16 * m;
                    const f32x4 x1a = acc[ai][0][m][0], x1b = acc[ai][0][m][1], x2a = acc[ai][1][m][0], x2b = acc[ai][1][m][1];
                    f32x4 o1a = x1a, o1b = x1b, o2a = x2a, o2b = x2b;
                    if (lat) { const int t = row & 4095; const f32x4 ca = *(const f32x4*)(ct + t * tstr), cb = *(const f32x4*)(ct + t * tstr + 4), sa = *(const f32x4*)(st + t * tstr), sb = *(const f32x4*)(st + t * tstr + 4);
                        o1a = x1a * ca - x2a * sa; o1b = x1b * cb - x2b * sb; o2a = x1a * sa + x2a * ca; o2b = x1b * sb + x2b * cb; }
                    if (g == 0) { store8(RQ + (size_t)row * 512 + col1, o1a, o1b); store8(RQ + (size_t)row * 512 + col2, o2a, o2b); }
                    else if (g == 1) { const int tc = row & 127; const float d0 = __builtin_amdgcn_exp2f(l2g0 * (float)(127 - tc)) * RKSCALE, d1 = __builtin_amdgcn_exp2f(l2g1 * (float)tc) * RKSCALE;
                        bf16_t* p0 = RKD + (size_t)row * 512; bf16_t* p1 = p0 + (size_t)MTOT * 512;
                        store8(p0 + col1, o1a * d0, o1b * d0); store8(p0 + col2, o2a * d0, o2b * d0); store8(p1 + col1, o1a * d1, o1b * d1); store8(p1 + col2, o2a * d1, o2b * d1); }
                    else if (g == 4) { store8(DQ + (size_t)row * 512 + col1, o1a * QSCALE, o1b * QSCALE); store8(DQ + (size_t)row * 512 + col2, o2a * QSCALE, o2b * QSCALE); }
                    else { const size_t kvrow = lat ? (size_t)(row >> 12) * KVL + 256 + (row & 4095) : (size_t)(u.pm - MLAT / 256) * KVL + (row & 255);
                        store8(DK + kvrow * 512 + col1, o1a, o1b); store8(DK + kvrow * 512 + col2, o2a, o2b); }
                }
        } else {
            const int col1 = 256 * sub + ub, col2 = col1 + 128;
#pragma unroll
            for (int ai = 0; ai < 2; ++ai)
#pragma unroll
                for (int m = 0; m < 4; ++m) {
                    const int row = row0 + 128 * ai + 16 * m;
                    if (g == 2) { store8(RV + (size_t)row * 512 + col1, acc[ai][0][m][0], acc[ai][0][m][1]); store8(RV + (size_t)row * 512 + col2, acc[ai][1][m][0], acc[ai][1][m][1]); }
                    else if (g == 3) { store8(RG + (size_t)row * 512 + col1, silu4(acc[ai][0][m][0]), silu4(acc[ai][0][m][1])); store8(RG + (size_t)row * 512 + col2, silu4(acc[ai][1][m][0]), silu4(acc[ai][1][m][1])); }
                    else { const size_t kvrow = lat ? (size_t)(row >> 12) * KVL + 256 + (row & 4095) : (size_t)(u.pm - MLAT / 256) * KVL + (row & 255);
                        store8(DV + kvrow * 512 + col1, acc[ai][0][m][0], acc[ai][0][m][1]); store8(DV + kvrow * 512 + col2, acc[ai][1][m][0], acc[ai][1][m][1]); }
                }
        }
    }
};


struct EpiWout {
    static constexpr bool PERM = false, AFTER_DRAIN = false;
    const float* x; const float* MOD; const float* GAM2; float* OUT; bf16_t* A2; float* rowss;
    __device__ __forceinline__ void operator()(const f32x4 (&acc)[2][2][4][2], const Unit& u, int wr, int wc, int fr, int fq) const {
        const int b = u.pm >> 4, col0 = u.pn * 256 + wc * 32 + 4 * fq, row0 = u.pm * 256 + wr * 64 + fr;
        f32x4 g1v[2][2], gm[2][2];
#pragma unroll
        for (int bj = 0; bj < 2; ++bj)
#pragma unroll
            for (int n = 0; n < 2; ++n) { g1v[bj][n] = *(const f32x4*)(MOD + b * NMOD + 2 * D + col0 + bj * 128 + n * 16); gm[bj][n] = *(const f32x4*)(GAM2 + b * D + col0 + bj * 128 + n * 16); }
#pragma unroll
        for (int ai = 0; ai < 2; ++ai)
#pragma unroll
            for (int m = 0; m < 4; ++m) { const int row = row0 + ai * 128 + m * 16; const size_t off = (size_t)row * D + col0; float s = 0.f;
#pragma unroll
                for (int bj = 0; bj < 2; ++bj)
#pragma unroll
                    for (int n = 0; n < 2; ++n) { const f32x4 xv = *(const f32x4*)(x + off + bj * 128 + n * 16); const f32x4 x1 = xv + g1v[bj][n] * acc[ai][bj][m][n];
                        *(f32x4*)(OUT + off + bj * 128 + n * 16) = x1; s += x1.x * x1.x + x1.y * x1.y + x1.z * x1.z + x1.w * x1.w; const f32x4 hq = x1 * gm[bj][n];
                        u32x2 w; w.x = cvt_pk_bf16(hq.x, hq.y); w.y = cvt_pk_bf16(hq.z, hq.w); *(u32x2*)(A2 + off + bj * 128 + n * 16) = w; }
                s += __shfl_xor(s, 16); s += __shfl_xor(s, 32);
                if (fq == 0) atomicAdd(rowss + row, s); }
    }
};
struct EpiUp {
    static constexpr bool PERM = true, AFTER_DRAIN = false;
    const float* rowss; const float* BIAS2; bf16_t* UH; int row_base;
    __device__ __forceinline__ void operator()(const f32x4 (&acc)[2][2][4][2], const Unit& u, int wr, int wc, int fr, int fq) const {
        const int b = (row_base + u.pm * 256) >> 12, ub = 32 * wc + 8 * fq, row0 = u.pm * 256 + wr * 64 + fr;
        f32x4 bv[2][2];
#pragma unroll
        for (int bj = 0; bj < 2; ++bj)
#pragma unroll
            for (int n = 0; n < 2; ++n) bv[bj][n] = *(const f32x4*)(BIAS2 + b * DFF2 + bj * DFF + 128 * u.pn + ub + 4 * n);
#pragma unroll
        for (int ai = 0; ai < 2; ++ai)
#pragma unroll
            for (int m = 0; m < 4; ++m) { const int row = row0 + ai * 128 + m * 16; const float rstd = rsqrtf(rowss[row_base + row] * (1.f / D) + EPS);
#pragma unroll
                for (int bj = 0; bj < 2; ++bj) store8(UH + (size_t)row * DFF2 + bj * DFF + 128 * u.pn + ub, acc[ai][bj][m][0] * rstd + bv[bj][0], acc[ai][bj][m][1] * rstd + bv[bj][1]); }
    }
};
struct EpiDown {
    static constexpr bool PERM = false, AFTER_DRAIN = false;
    const float* MOD; float* OUT;
    __device__ __forceinline__ void operator()(const f32x4 (&acc)[2][2][4][2], const Unit& u, int wr, int wc, int fr, int fq) const {
        const int b = u.pm >> 4, col0 = u.pn * 256 + wc * 32 + 4 * fq, row0 = u.pm * 256 + wr * 64 + fr;
        f32x4 g2v[2][2];
#pragma unroll
        for (int bj = 0; bj < 2; ++bj)
#pragma unroll
            for (int n = 0; n < 2; ++n) g2v[bj][n] = *(const f32x4*)(MOD + b * NMOD + 5 * D + col0 + bj * 128 + n * 16);
#pragma unroll
        for (int ai = 0; ai < 2; ++ai)
#pragma unroll
            for (int m = 0; m < 4; ++m) { const size_t off = (size_t)(row0 + ai * 128 + m * 16) * D + col0;
#pragma unroll
                for (int bj = 0; bj < 2; ++bj)
#pragma unroll
                    for (int n = 0; n < 2; ++n) { float* p = OUT + off + bj * 128 + n * 16; *(f32x4*)p = *(const f32x4*)p + g2v[bj][n] * acc[ai][bj][m][n]; } }
    }
};
__device__ __forceinline__ void cvt8(u32x4 w, float (&f)[8]) {
    f[0] = __uint_as_float(w.x << 16); f[1] = __uint_as_float(w.x & 0xffff0000u); f[2] = __uint_as_float(w.y << 16); f[3] = __uint_as_float(w.y & 0xffff0000u);
    f[4] = __uint_as_float(w.z << 16); f[5] = __uint_as_float(w.z & 0xffff0000u); f[6] = __uint_as_float(w.w << 16); f[7] = __uint_as_float(w.w & 0xffff0000u);
}


__device__ __forceinline__ void conv_phase(const bf16_t* __restrict__ UH, bf16_t* __restrict__ Gm, const float* __restrict__ conv_w, const float* __restrict__ conv_b, int row_base, int gt, int T) {
    const int groups = T / 352, rpg = (16384 + groups - 1) / groups;
    if (gt >= groups * 352) return;
    const int grp = gt / 352, jc = gt % 352, j0 = 8 * jc;
    float w0a[8], w1a[8], w2a[8], cba[8], w0b[8], w1b[8], w2b[8], cbb[8];
#pragma unroll
    for (int i = 0; i < 8; ++i) { w0a[i] = conv_w[j0 + i]; w0b[i] = conv_w[DFF + j0 + i]; w1a[i] = conv_w[DFF2 + j0 + i]; w1b[i] = conv_w[DFF2 + DFF + j0 + i];
        w2a[i] = conv_w[2 * DFF2 + j0 + i]; w2b[i] = conv_w[2 * DFF2 + DFF + j0 + i]; cba[i] = conv_b[j0 + i]; cbb[i] = conv_b[DFF + j0 + i]; }
    const int r0 = grp * rpg, r1 = (r0 + rpg < 16384) ? r0 + rpg : 16384;
    if (r0 >= r1) return;
    float pa[8], pb[8], ca[8], cb[8], na[8], nb[8];
    { const int t = (row_base + r0) & 4095;
      if (t > 0) { cvt8(*(const u32x4*)(UH + (size_t)(r0 - 1) * DFF2 + j0), pa); cvt8(*(const u32x4*)(UH + (size_t)(r0 - 1) * DFF2 + DFF + j0), pb); }
      else {
#pragma unroll
          for (int i = 0; i < 8; ++i) { pa[i] = 0.f; pb[i] = 0.f; } }
      cvt8(*(const u32x4*)(UH + (size_t)r0 * DFF2 + j0), ca); cvt8(*(const u32x4*)(UH + (size_t)r0 * DFF2 + DFF + j0), cb); }
    for (int r = r0; r < r1; ++r) {
        const int t = (row_base + r) & 4095;
        if (r + 1 < 16384) { cvt8(*(const u32x4*)(UH + (size_t)(r + 1) * DFF2 + j0), na); cvt8(*(const u32x4*)(UH + (size_t)(r + 1) * DFF2 + DFF + j0), nb); }
        else {
#pragma unroll
            for (int i = 0; i < 8; ++i) { na[i] = 0.f; nb[i] = 0.f; } }
        float o[8];
#pragma unroll
        for (int i = 0; i < 8; ++i) { const float pva = t > 0 ? pa[i] : 0.f, pvb = t > 0 ? pb[i] : 0.f, nva = t < 4095 ? na[i] : 0.f, nvb = t < 4095 ? nb[i] : 0.f;
            const float a = cba[i] + w0a[i] * pva + w1a[i] * ca[i] + w2a[i] * nva, bq = cbb[i] + w0b[i] * pvb + w1b[i] * cb[i] + w2b[i] * nvb; o[i] = siluf(a) * bq; }
        u32x4 w; w.x = cvt_pk_bf16(o[0], o[1]); w.y = cvt_pk_bf16(o[2], o[3]); w.z = cvt_pk_bf16(o[4], o[5]); w.w = cvt_pk_bf16(o[6], o[7]);
        *(u32x4*)(Gm + (size_t)(row_base + r) * DFF + j0) = w;
#pragma unroll
        for (int i = 0; i < 8; ++i) { pa[i] = ca[i]; pb[i] = cb[i]; ca[i] = na[i]; cb[i] = nb[i]; }
    }
}

__global__ void __launch_bounds__(NTHR, 2) mk_fwd(Args args) {
    __builtin_assume(threadIdx.y == 0); __builtin_assume(threadIdx.z == 0);
    extern __shared__ __attribute__((aligned(16))) unsigned char lds_raw[];
    LAS unsigned char* lds = (LAS unsigned char*)lds_raw;
    cg::grid_group grid = cg::this_grid();
    const int wave = __builtin_amdgcn_readfirstlane(threadIdx.x >> 6), wg = blockIdx.x, G = gridDim.x;
#define lane lane_now()
#define tid (wave * 64 + lane_now())
    unsigned char* ws = args.ws;
    const float* x = args.in[0]; const float* c = args.in[1]; const float* ctx = args.in[2]; const float* c_ctx = args.in[3];
    const float* w_mod = args.in[4]; const float* b_mod = args.in[5]; const float* norm1_g = args.in[6]; const float* w_in = args.in[7];
    const float* decay_logit = args.in[8]; const float* diff_lambda = args.in[10];
    const float* w_out = args.in[12]; const float* norm2_g = args.in[13]; const float* w_up = args.in[14]; const float* w_down = args.in[17];
    float* MOD = (float*)(ws + WS_MOD); float* GAM2 = (float*)(ws + WS_GAM2); float* BIAS2 = (float*)(ws + WS_BIAS2); float* MISC = (float*)(ws + WS_MISC);
    float* cosr = (float*)(ws + WS_COSR); float* sinr = (float*)(ws + WS_SINR); float* cosd = (float*)(ws + WS_COSD); float* sind = (float*)(ws + WS_SIND);
    bf16_t* WinT = (bf16_t*)(ws + WS_WIN); bf16_t* WoutT = (bf16_t*)(ws + WS_WOUT); bf16_t* WupT = (bf16_t*)(ws + WS_WUP); bf16_t* WdownT = (bf16_t*)(ws + WS_WDOWN);
    bf16_t* XN = (bf16_t*)(ws + WS_XN); bf16_t* YA = (bf16_t*)(ws + WS_YA); bf16_t* A2 = (bf16_t*)(ws + WS_A2); bf16_t* UH = (bf16_t*)(ws + WS_UH); bf16_t* Gb = (bf16_t*)(ws + WS_G); float* rowss = (float*)(ws + WS_ROWSS);
    const float* gn_g = args.in[9]; const float* subln_g = args.in[11]; const float* conv_w = args.in[15]; const float* conv_b = args.in[16]; const float* final_g = args.in[18];
    const int lo = args.ph_lo, hi = args.ph_hi;
#define IN(k) (lo <= (k) && (k) < hi)
#define SEAM(k) do { if (IN(k) && IN((k) + 1)) grid.sync(); } while (0)

    if (IN(0)) {
        LAS float* sc = (LAS float*)lds; LAS float* red = sc + 9 * 1024;
        for (int i = tid; i < 9 * 1024; i += NTHR) { const int r = i >> 10, k = i & 1023; sc[i] = siluf(r < 8 ? c[r * D + k] : c_ctx[k]); }
        __syncthreads();
        for (int cw = wg; cw < 256; cw += G) {
            const int ks = tid / 24, col = tid % 24;
            if (tid < 504) {
                float a[9];
#pragma unroll
                for (int r = 0; r < 9; ++r) a[r] = 0.f;
                for (int k = ks; k < D; k += 21) { const float w = w_mod[(size_t)k * NMOD + 24 * cw + col];
#pragma unroll
                    for (int r = 0; r < 9; ++r) a[r] += sc[r * 1024 + k] * w; }
#pragma unroll
                for (int r = 0; r < 9; ++r) red[(ks * 24 + col) * 9 + r] = a[r];
            }
            __syncthreads();
            if (tid < 216) { const int cc = tid / 9, r = tid % 9; float s = 0.f; for (int q = 0; q < 21; ++q) s += red[(q * 24 + cc) * 9 + r]; MOD[r * NMOD + 24 * cw + cc] = s + b_mod[24 * cw + cc]; }
            __syncthreads();
        }
        {
            LAS float* scr = (LAS float*)(lds + wave * 8448);
            constexpr int I_IN = 16 * (INC / 32), I_OUT = 16 * (D / 32), I_UP = 16 * (DFF2 / 32), I_DN = (DFF / 64) * (D / 32), NIT = I_IN + I_OUT + I_UP + I_DN;
            for (int it = wg * NWAVES + wave; it < NIT; it += G * NWAVES) {
                int r = it;
                if (r < I_IN) { const int nb = r % (INC / 32), kb = r / (INC / 32); transpose_item(w_in, D, INC, WinT, 64 * kb, 32 * nb, colmap_in(32 * nb), scr, lane); continue; } r -= I_IN;
                if (r < I_OUT) { const int nb = r % (D / 32), kb = r / (D / 32); transpose_item(w_out, D, D, WoutT, 64 * kb, 32 * nb, 32 * nb, scr, lane); continue; } r -= I_OUT;
                if (r < I_UP) { const int nb = r % (DFF2 / 32), kb = r / (DFF2 / 32); transpose_item(w_up, D, DFF2, WupT, 64 * kb, 32 * nb, colmap_up(32 * nb), scr, lane); continue; } r -= I_UP;
                { const int nb = r % (D / 32), kb = r / (D / 32); transpose_item(w_down, DFF, D, WdownT, 64 * kb, 32 * nb, 32 * nb, scr, lane); }
            }
        }
        for (int idx = wg * NTHR + tid; idx < SEQ * 96; idx += G * NTHR) {
            if (idx < SEQ * 64) { const int pos = idx >> 6, j = idx & 63; const float inv = powf(10000.f, -(float)(j & 31) / 32.f); const float p = (j < 32) ? (float)(pos >> 6) : (float)(pos & 63); const float a = p * inv; cosr[idx] = cosf(a); sinr[idx] = sinf(a); }
            else { const int i2 = idx - SEQ * 64, pos = i2 >> 5, j = i2 & 31; const float inv = powf(10000.f, -(float)(j & 15) / 16.f); const float p = (j < 16) ? (float)(pos >> 6) : (float)(pos & 63); const float a = p * inv; cosd[i2] = cosf(a); sind[i2] = sinf(a); }
        }
        if (wg == 0 && tid == 0) { float a = 0.f, bb = 0.f; for (int i = 0; i < 64; ++i) { a += diff_lambda[i] * diff_lambda[64 + i]; bb += diff_lambda[128 + i] * diff_lambda[192 + i]; } MISC[0] = expf(a) - expf(bb) + LAMBDA_INIT; }
        __syncthreads();
    }
    SEAM(0);
    if (IN(1)) {
        const int nwv = G * NWAVES, gw = wg * NWAVES + wave, rpw = (MTOT + nwv - 1) / nwv;
        int curb = -1; f32x4 gam[4], shv[4];
        for (int m = gw * rpw; m < (gw + 1) * rpw && m < MTOT; ++m) {
            const int r = m < MLAT ? (m >> 12) : 8;
            if (r != curb) { curb = r; const float* sh = MOD + r * NMOD; const float* scp = sh + D;
#pragma unroll
                for (int j = 0; j < 4; ++j) { const int k = 4 * lane + 256 * j; gam[j] = *(const f32x4*)(norm1_g + k) * (1.f + *(const f32x4*)(scp + k)); shv[j] = *(const f32x4*)(sh + k); } }
            const float* xr = m < MLAT ? x + (size_t)m * D : ctx + (size_t)(m - MLAT) * D;
            f32x4 v[4]; float s = 0.f;
#pragma unroll
            for (int j = 0; j < 4; ++j) { v[j] = *(const f32x4*)(xr + 4 * lane + 256 * j); s += v[j].x * v[j].x + v[j].y * v[j].y + v[j].z * v[j].z + v[j].w * v[j].w; }
            const float rstd = rsqrtf(wave_sum(s) * (1.f / D) + EPS);
#pragma unroll
            for (int j = 0; j < 4; ++j) { const f32x4 h = v[j] * rstd * gam[j] + shv[j]; u32x2 w; w.x = cvt_pk_bf16(h.x, h.y); w.y = cvt_pk_bf16(h.z, h.w); *(u32x2*)(XN + (size_t)m * D + 4 * lane + 256 * j) = w; }
        }
        const int gt = wg * NTHR + tid;
        if (gt < NB * D) { const int b = gt / D, k = gt % D; GAM2[gt] = norm2_g[k] * (1.f + MOD[b * NMOD + 4 * D + k]); }
        else if (gt < NB * D + DFF2) { const int n = gt - NB * D; float a[8];
#pragma unroll
            for (int b = 0; b < 8; ++b) a[b] = 0.f;
            for (int k = 0; k < D; ++k) { const float w = w_up[(size_t)k * DFF2 + n];
#pragma unroll
                for (int b = 0; b < 8; ++b) a[b] += MOD[b * NMOD + 3 * D + k] * w; }
#pragma unroll
            for (int b = 0; b < 8; ++b) BIAS2[b * DFF2 + n] = a[b]; }
    }
    SEAM(1);
    if (IN(2)) {
        Gemm g{XN, WinT, MTOT, INC, D}; StaticOrder S; S.init(MTOT, INC, G, wg);
        EpiWin E{(bf16_t*)(ws + WS_RQ), (bf16_t*)(ws + WS_RKD), (bf16_t*)(ws + WS_RV), (bf16_t*)(ws + WS_RG), (bf16_t*)(ws + WS_DQ), (bf16_t*)(ws + WS_DK), (bf16_t*)(ws + WS_DV), cosr, sinr, cosd, sind, decay_logit};
        pg8::gemm_phase<EpiWin, StaticOrder, true, true>(lds, g, S, E, wave);
    }
    SEAM(2);
    if (IN(3)) {
        for (int u = wg; u < 512; u += G) { const int slot = (u + (u >> 8)) & 7, d = (u >> 3) & 1, h = (u >> 4) & 3, b = (u >> 6) & 7;
            rt::r1_unit(b, h, d, slot, (const bf16_t*)(ws + WS_RKD), (const bf16_t*)(ws + WS_RV), decay_logit, (float*)(ws + WS_E), (LAS char*)lds, wave); }
    }
    SEAM(3);
    if (IN(4)) {
        const bf16_t* RQ = (const bf16_t*)(ws + WS_RQ); const bf16_t* RKD = (const bf16_t*)(ws + WS_RKD); const bf16_t* RV = (const bf16_t*)(ws + WS_RV); const bf16_t* RG = (const bf16_t*)(ws + WS_RG);
        const bf16_t* DQ = (const bf16_t*)(ws + WS_DQ); const bf16_t* DK = (const bf16_t*)(ws + WS_DK); const bf16_t* DV = (const bf16_t*)(ws + WS_DV);
        float* TMP = (float*)(ws + WS_TMP);
        for (int u = wg; u < 256; u += G)
            rt::r3_unit(u >> 5, (u >> 3) & 3, u & 7, RQ, RKD, RV, RG, decay_logit, gn_g, (const float*)(ws + WS_E), TMP, YA, (LAS char*)lds, wave);
        {
            const float lam = MISC[0];
            const int vcu = (G % 8 == 0) ? (wg % 8) * (G / 8) + wg / 8 : wg;
            for (int u = vcu; u < 1024; u += G) {
                const int h = u >> 8, b = (u & 255) >> 5, qblk = u & 31; const size_t m0 = (size_t)b * SEQ + qblk * 128;
                da::attn_unit(DQ + m0 * 512 + h * 128, DK + (size_t)b * KVL * 512 + h * 128, DV + (size_t)b * KVL * 512 + h * 128, YA + m0 * 1024 + 512 + h * 128, subln_g + h * 128, lam, (char*)lds_raw, wave);
            }
        }
    }
    SEAM(4);
    if (IN(5)) {
        Gemm g{YA, WoutT, MLAT, D, D}; StaticOrder S; S.init(MLAT, D, G, wg);
        EpiWout E{x, MOD, GAM2, args.out, A2, rowss};
        pg8::gemm_phase<EpiWout, StaticOrder, true, true>(lds, g, S, E, wave);
    }
    SEAM(5);
#define UP_HALF(hf) do { \
        if (IN(6 + 2 * (hf))) { \
            Gemm g{A2 + (size_t)(hf) * 16384 * D, WupT, 16384, DFF2, D}; StaticOrder S; S.init(16384, DFF2, G, wg); \
            EpiUp E{rowss, BIAS2, UH, (hf) * 16384}; \
            pg8::gemm_phase<EpiUp, StaticOrder, true, true>(lds, g, S, E, wave); \
        } \
        SEAM(6 + 2 * (hf)); \
        if (IN(7 + 2 * (hf))) conv_phase(UH, Gb, conv_w, conv_b, (hf) * 16384, wg * NTHR + tid, G * NTHR); \
        SEAM(7 + 2 * (hf)); } while (0)
    UP_HALF(0);
    UP_HALF(1);
#undef UP_HALF
    if (IN(10)) {
        Gemm g{Gb, WdownT, MLAT, D, DFF}; StaticOrder S; S.init(MLAT, D, G, wg);
        EpiDown E{MOD, args.out};
        pg8::gemm_phase<EpiDown, StaticOrder, true, true>(lds, g, S, E, wave);
    }
    SEAM(10);
    if (IN(11)) {
        const int nwv = G * NWAVES;
        for (int m = wg * NWAVES + wave; m < MLAT; m += nwv) {
            float* xr = args.out + (size_t)m * D; f32x4 v[4]; float s = 0.f;
#pragma unroll
            for (int j = 0; j < 4; ++j) { v[j] = *(const f32x4*)(xr + 4 * lane + 256 * j); s += v[j].x * v[j].x + v[j].y * v[j].y + v[j].z * v[j].z + v[j].w * v[j].w; }
            const float rstd = rsqrtf(wave_sum(s) * (1.f / D) + EPS);
#pragma unroll
            for (int j = 0; j < 4; ++j) *(f32x4*)(xr + 4 * lane + 256 * j) = v[j] * rstd * *(const f32x4*)(final_g + 4 * lane + 256 * j);
        }
    }
#undef IN
#undef SEAM
#undef lane
#undef tid
}
}
#ifndef OPT_LEVEL
#define OPT_LEVEL 2
#endif
static int mk_grid = 0;
static void mk_launch(mk::Args a, int lo, int hi, hipStream_t stream) {
    a.ph_lo = lo; a.ph_hi = hi; void* args[] = {&a};
    hipError_t e = hipLaunchCooperativeKernel((const void*)mk::mk_fwd, dim3(mk_grid), dim3(mk::NTHR), args, mk::LDS_BYTES, stream);
    if (e != hipSuccess) fprintf(stderr, "cooperative launch failed: %s (grid %d)\n", hipGetErrorString(e), mk_grid);
}
extern "C" void kernel_launch(void* const* d_in, const int* in_sizes, int n_in, void* d_out, int out_size, void* d_ws, size_t ws_size, hipStream_t stream) {
    if (ws_size < WS_END || n_in != 19) { fprintf(stderr, "kernel_launch: ws too small %zu or n_in %d\n", ws_size, n_in); return; }
    if (mk_grid == 0) {
        int dev = 0, cus = 0, per_cu = 0; (void)hipGetDevice(&dev); (void)hipDeviceGetAttribute(&cus, hipDeviceAttributeMultiprocessorCount, dev);
        if (hipFuncSetAttribute((const void*)mk::mk_fwd, hipFuncAttributeMaxDynamicSharedMemorySize, mk::LDS_BYTES) != hipSuccess) fprintf(stderr, "hipFuncSetAttribute failed\n");
        if (hipOccupancyMaxActiveBlocksPerMultiprocessor(&per_cu, (const void*)mk::mk_fwd, mk::NTHR, mk::LDS_BYTES) != hipSuccess || per_cu < 1) { fprintf(stderr, "occupancy query: %d\n", per_cu); per_cu = 1; }
        if (per_cu > 1) per_cu = 1;
        mk_grid = cus * per_cu; fprintf(stderr, "mk grid = %d (cus %d)\n", mk_grid, cus);
    }
    const float* x = (const float*)d_in[0]; const float* c = (const float*)d_in[1]; const float* ctx = (const float*)d_in[2]; const float* c_ctx = (const float*)d_in[3];
    const float* w_mod = (const float*)d_in[4]; const float* b_mod = (const float*)d_in[5]; const float* norm1_g = (const float*)d_in[6]; const float* w_in = (const float*)d_in[7];
    const float* decay_logit = (const float*)d_in[8]; const float* gn_g = (const float*)d_in[9]; const float* diff_lambda = (const float*)d_in[10]; const float* subln_g = (const float*)d_in[11];
    const float* w_out = (const float*)d_in[12]; const float* norm2_g = (const float*)d_in[13]; const float* w_up = (const float*)d_in[14]; const float* conv_w = (const float*)d_in[15];
    const float* conv_b = (const float*)d_in[16]; const float* w_down = (const float*)d_in[17]; const float* final_g = (const float*)d_in[18];
    char* ws = (char*)d_ws; float* out = (float*)d_out;
    float* MOD = (float*)(ws + WS_MOD); float* GAM2 = (float*)(ws + WS_GAM2); float* BIAS2 = (float*)(ws + WS_BIAS2); float* MISC = (float*)(ws + WS_MISC); float* rowss = (float*)(ws + WS_ROWSS);
    float* cosr = (float*)(ws + WS_COSR); float* sinr = (float*)(ws + WS_SINR); float* cosd = (float*)(ws + WS_COSD); float* sind = (float*)(ws + WS_SIND);
    bf16_t* XN = (bf16_t*)(ws + WS_XN); float* TMP = (float*)(ws + WS_TMP); bf16_t* A2 = (bf16_t*)(ws + WS_A2);
    bf16_t* YA = (bf16_t*)(ws + WS_YA); bf16_t* G = (bf16_t*)(ws + WS_G); bf16_t* UH = (bf16_t*)(ws + WS_UH);
    nv::P1Out po{(bf16_t*)(ws + WS_RQ), (bf16_t*)(ws + WS_RKD), (bf16_t*)(ws + WS_RV), (bf16_t*)(ws + WS_RG), (bf16_t*)(ws + WS_DQ), (bf16_t*)(ws + WS_DK), (bf16_t*)(ws + WS_DV), cosr, sinr, cosd, sind, decay_logit};
    mk::Args a{}; for (int i = 0; i < 19; ++i) a.in[i] = (const float*)d_in[i]; a.out = out; a.ws = (unsigned char*)d_ws;
    (void)hipMemsetAsync(ws + WS_ZERO, 0, ZERO_BYTES, stream);
#if OPT_LEVEL == 3
    mk_launch(a, 0, 3, stream);
    nv::k_ret<<<32, 128, 0, stream>>>(po.RQ, po.RKD, po.RV, po.RG, decay_logit, gn_g, TMP, YA);
    nv::k_attn<<<dim3(MLAT / 64, 4), 256, 0, stream>>>(po.DQ, po.DK, po.DV, subln_g, MISC, YA);
    mk_launch(a, 5, 12, stream);
    return;
#elif OPT_LEVEL == 2
    mk_launch(a, 0, 12, stream);
    return;
#elif OPT_LEVEL >= 1
    mk_launch(a, 0, 3, stream);
#else
    nv::k_mod<<<(9 * NMOD + 255) / 256, 256, 0, stream>>>(c, c_ctx, w_mod, b_mod, MOD);
    nv::k_small<<<(SEQ * 64 + 255) / 256, 256, 0, stream>>>(MOD, norm2_g, w_up, diff_lambda, GAM2, BIAS2, MISC, cosr, sinr, cosd, sind);
    nv::k_xn<<<MTOT / 4, 256, 0, stream>>>(x, ctx, MOD, norm1_g, XN);
    { float* scr = (float*)(ws + WS_SCR);
    for (int g = 0; g < 7; ++g) {
        nv::k_gemm<<<dim3(512 / 64, MTOT / 64), 256, 0, stream>>>(XN, D, w_in, INC, 512 * g, scr, 512, D);
        nv::k_p1post<<<MTOT, 256, 0, stream>>>(scr, g, po);
    } }
#endif
    nv::k_ret<<<32, 128, 0, stream>>>(po.RQ, po.RKD, po.RV, po.RG, decay_logit, gn_g, TMP, YA);
    nv::k_attn<<<dim3(MLAT / 64, 4), 256, 0, stream>>>(po.DQ, po.DK, po.DV, subln_g, MISC, YA);
    float* scr2 = (float*)(ws + WS_SCR2);
    nv::k_gemm<<<dim3(D / 64, MLAT / 64), 256, 0, stream>>>(YA, D, w_out, D, 0, scr2, D, D);
    nv::k_post_wout<<<MLAT / 4, 256, 0, stream>>>(scr2, x, MOD, GAM2, out, A2, rowss);
    float* scr3 = (float*)(ws + WS_SCR3);
    for (int hf = 0; hf < 2; ++hf) {
        for (int nb = 0; nb < DFF2 / 512; ++nb) {
            nv::k_gemm<<<dim3(512 / 64, 16384 / 64), 256, 0, stream>>>(A2 + (size_t)hf * 16384 * D, D, w_up, DFF2, 512 * nb, scr3, 512, D);
            nv::k_post_up<<<16384, 256, 0, stream>>>(scr3, 512 * nb, hf * 16384, rowss, BIAS2, UH);
        }
        nv::k_conv<<<16384, 256, 0, stream>>>(UH, hf * 16384, conv_w, conv_b, G);
    }
    float* scr4 = (float*)(ws + WS_SCR4);
    nv::k_gemm<<<dim3(D / 64, MLAT / 64), 256, 0, stream>>>(G, DFF, w_down, D, 0, scr4, D, DFF);
    nv::k_post_down<<<MLAT / 4, 256, 0, stream>>>(scr4, MOD, final_g, out);
}
```

```cpp
#include <hip/hip_runtime.h>
#include <hip/hip_bf16.h>
#include <cstdio>
#include <cstdint>

typedef unsigned short bf16_t;
typedef float f32x4 __attribute__((ext_vector_type(4)));
typedef unsigned u32x4 __attribute__((ext_vector_type(4)));
typedef unsigned u32x2 __attribute__((ext_vector_type(2)));

constexpr int D = 1024, NB = 8, SEQ = 4096, CTXL = 256, MLAT = NB * SEQ, MCTX = NB * CTXL, MTOT = MLAT + MCTX;
constexpr int INC = 3584, DFF = 2816, DFF2 = 5632, KVL = SEQ + CTXL, NMOD = 6 * D;
constexpr float EPS = 1e-6f, GN_EPS = 1e-5f;
constexpr float LAMBDA_INIT = 0.2f;
constexpr float QSCALE = 0.125f * 1.4426950408889634f;
constexpr float RKSCALE = 0.088388347648318440f;

constexpr size_t MiB = 1u << 20;
constexpr size_t WS_ZERO = 0, ZERO_BYTES = 1 * MiB;
constexpr size_t WS_ROWSS = 0;
constexpr size_t WS_MISC = 512 * 1024;
constexpr size_t WS_XBAR = 640 * 1024;
constexpr size_t WS_MOD = 1 * MiB;
constexpr size_t WS_GAM2 = WS_MOD + 256 * 1024;
constexpr size_t WS_BIAS2 = WS_GAM2 + 64 * 1024;
constexpr size_t WS_ROPE = 2 * MiB;
constexpr size_t WS_COSR = WS_ROPE, WS_SINR = WS_ROPE + 1 * MiB, WS_COSD = WS_ROPE + 2 * MiB, WS_SIND = WS_COSD + 512 * 1024;
constexpr size_t WS_MODP = 5 * MiB;
constexpr size_t WS_WIN = 10 * MiB, WS_WOUT = 18 * MiB, WS_WUP = 20 * MiB, WS_WDOWN = 32 * MiB;
constexpr size_t WS_RA = 40 * MiB;
constexpr size_t WS_XN = WS_RA, WS_TMP = WS_RA, WS_A2 = WS_RA + 1 * MiB;
constexpr size_t WS_RQ = 112 * MiB;
constexpr size_t WS_RKD = WS_RQ + 32 * MiB;
constexpr size_t WS_RV = WS_RKD + 68 * MiB;
constexpr size_t WS_RG = WS_RV + 34 * MiB;
constexpr size_t WS_DQ = WS_RG + 32 * MiB;
constexpr size_t WS_DK = WS_DQ + 32 * MiB;
constexpr size_t WS_DV = WS_DK + 34 * MiB;
constexpr size_t WS_E = WS_DV + 34 * MiB;
constexpr size_t WS_YA = 414 * MiB;
constexpr size_t WS_SCR = 414 * MiB;
constexpr size_t WS_G = 112 * MiB;
constexpr size_t WS_UH = 288 * MiB;
constexpr size_t WS_SCR2 = 112 * MiB;
constexpr size_t WS_SCR3 = 464 * MiB;
constexpr size_t WS_SCR4 = 288 * MiB;
constexpr size_t WS_END = 512 * MiB;
static_assert(WS_E == 378 * MiB, "map");

__device__ __forceinline__ float bf2f(bf16_t v) { return __uint_as_float((unsigned)v << 16); }
__device__ __forceinline__ bf16_t f2bf(float f) { unsigned u = __float_as_uint(f); return (bf16_t)((u + 0x7fffu + ((u >> 16) & 1u)) >> 16); }
__device__ __forceinline__ float siluf(float v) { return v / (1.f + __expf(-v)); }
__device__ __forceinline__ float wave_sum(float v) {
#pragma unroll
    for (int o = 1; o < 64; o <<= 1) v += __shfl_xor(v, o);
    return v;
}
__device__ __forceinline__ int lane_now() { int l; asm volatile("v_mbcnt_lo_u32_b32 %0, -1, 0\n\tv_mbcnt_hi_u32_b32 %0, -1, %0" : "=v"(l)); return l; }
__device__ __forceinline__ float log_sigmoid(float x) { return -log1pf(expf(-x)); }

namespace nv {
__global__ void __launch_bounds__(256) k_mod(const float* __restrict__ c, const float* __restrict__ c_ctx, const float* __restrict__ w_mod, const float* __restrict__ b_mod, float* __restrict__ MOD) {
    const int idx = blockIdx.x * 256 + threadIdx.x;
    if (idx >= 9 * NMOD) return;
    const int r = idx / NMOD, j = idx % NMOD;
    const float* cv = r < 8 ? c + r * D : c_ctx;
    float s = 0.f;
    for (int k = 0; k < D; ++k) s += siluf(cv[k]) * w_mod[(size_t)k * NMOD + j];
    MOD[idx] = s + b_mod[j];
}
__global__ void __launch_bounds__(256) k_small(const float* __restrict__ MOD, const float* __restrict__ norm2_g, const float* __restrict__ w_up, const float* __restrict__ diff_lambda,
                                               float* __restrict__ GAM2, float* __restrict__ BIAS2, float* __restrict__ MISC, float* cosr, float* sinr, float* cosd, float* sind) {
    const int idx = blockIdx.x * 256 + threadIdx.x;
    if (idx < NB * D) { const int b = idx / D, k = idx % D; GAM2[idx] = norm2_g[k] * (1.f + MOD[b * NMOD + 4 * D + k]); }
    if (idx < NB * DFF2) { const int b = idx / DFF2, n = idx % DFF2; float s = 0.f; for (int k = 0; k < D; ++k) s += MOD[b * NMOD + 3 * D + k] * w_up[(size_t)k * DFF2 + n]; BIAS2[idx] = s; }
    if (idx == 0) { float a = 0.f, bb = 0.f; for (int i = 0; i < 64; ++i) { a += diff_lambda[i] * diff_lambda[64 + i]; bb += diff_lambda[128 + i] * diff_lambda[192 + i]; } MISC[0] = expf(a) - expf(bb) + LAMBDA_INIT; }
    if (idx < SEQ * 64) { const int pos = idx >> 6, j = idx & 63; const float inv = powf(10000.f, -(float)(j & 31) / 32.f); const float p = (j < 32) ? (float)(pos >> 6) : (float)(pos & 63); const float a = p * inv; cosr[idx] = cosf(a); sinr[idx] = sinf(a); }
    if (idx < SEQ * 32) { const int pos = idx >> 5, j = idx & 31; const float inv = powf(10000.f, -(float)(j & 15) / 16.f); const float p = (j < 16) ? (float)(pos >> 6) : (float)(pos & 63); const float a = p * inv; cosd[idx] = cosf(a); sind[idx] = sinf(a); }
}
__global__ void __launch_bounds__(256) k_xn(const float* __restrict__ x, const float* __restrict__ ctx, const float* __restrict__ MOD, const float* __restrict__ g, bf16_t* __restrict__ XN) {
    const int lane = threadIdx.x & 63, m = blockIdx.x * 4 + (threadIdx.x >> 6);
    if (m >= MTOT) return;
    const float* xr = m < MLAT ? x + (size_t)m * D : ctx + (size_t)(m - MLAT) * D;
    const int r = m < MLAT ? (m >> 12) : 8;
    const float* sh = MOD + r * NMOD, * sc = sh + D;
    f32x4 v[4]; float s = 0.f;
#pragma unroll
    for (int j = 0; j < 4; ++j) { v[j] = *(const f32x4*)(xr + 4 * lane + 256 * j); s += v[j].x * v[j].x + v[j].y * v[j].y + v[j].z * v[j].z + v[j].w * v[j].w; }
    const float rstd = rsqrtf(wave_sum(s) * (1.f / D) + EPS);
#pragma unroll
    for (int j = 0; j < 4; ++j) { const int k = 4 * lane + 256 * j; const f32x4 gg = *(const f32x4*)(g + k), a = *(const f32x4*)(sc + k), bq = *(const f32x4*)(sh + k);
        const f32x4 h = v[j] * rstd * gg * (1.f + a) + bq;
        u32x2 w; w.x = f2bf(h.x) | ((unsigned)f2bf(h.y) << 16); w.y = f2bf(h.z) | ((unsigned)f2bf(h.w) << 16); *(u32x2*)(XN + (size_t)m * D + k) = w; }
}
__global__ void __launch_bounds__(256) k_gemm(const bf16_t* __restrict__ A, int lda, const float* __restrict__ W, int ldw, int n0, float* __restrict__ C, int ldc, int K) {
    __shared__ float As[16][65], Bs[16][65];
    const int tx = threadIdx.x & 15, ty = threadIdx.x >> 4, m0 = blockIdx.y * 64, nb = blockIdx.x * 64;
    float acc[4][4];
#pragma unroll
    for (int i = 0; i < 4; ++i)
#pragma unroll
        for (int j = 0; j < 4; ++j) acc[i][j] = 0.f;
    for (int k0 = 0; k0 < K; k0 += 16) {
#pragma unroll
        for (int i = 0; i < 4; ++i) { const int e = threadIdx.x + 256 * i, r = e >> 4, cc = e & 15; As[cc][r] = bf2f(A[(size_t)(m0 + r) * lda + k0 + cc]); }
#pragma unroll
        for (int i = 0; i < 4; ++i) { const int e = threadIdx.x + 256 * i, r = e >> 6, cc = e & 63; Bs[r][cc] = W[(size_t)(k0 + r) * ldw + n0 + nb + cc]; }
        __syncthreads();
#pragma unroll
        for (int kk = 0; kk < 16; ++kk) { float a[4], b[4];
#pragma unroll
            for (int i = 0; i < 4; ++i) { a[i] = As[kk][ty * 4 + i]; b[i] = Bs[kk][tx * 4 + i]; }
#pragma unroll
            for (int i = 0; i < 4; ++i)
#pragma unroll
                for (int j = 0; j < 4; ++j) acc[i][j] += a[i] * b[j]; }
        __syncthreads();
    }
#pragma unroll
    for (int i = 0; i < 4; ++i) *(f32x4*)(C + (size_t)(m0 + ty * 4 + i) * ldc + nb + tx * 4) = (f32x4){acc[i][0], acc[i][1], acc[i][2], acc[i][3]};
}
struct P1Out { bf16_t *RQ, *RKD, *RV, *RG, *DQ, *DK, *DV; const float *cosr, *sinr, *cosd, *sind; const float* decay_logit; };
__global__ void __launch_bounds__(256) k_p1post(const float* __restrict__ P, int g, P1Out o) {
    const int m = blockIdx.x, c = threadIdx.x;
    const bool lat = m < MLAT; const int b = lat ? (m >> 12) : ((m - MLAT) >> 8), t = lat ? (m & 4095) : ((m - MLAT) & 255);
    const float* pr = P + (size_t)m * 512;
    if (g == 0 || g == 1) {
        const int h = c >> 6, j = c & 63, c1 = 128 * h + j, c2 = c1 + 64;
        float x1 = pr[c1], x2 = pr[c2], o1 = x1, o2 = x2;
        if (lat) { const float cs = o.cosr[t * 64 + j], sn = o.sinr[t * 64 + j]; o1 = x1 * cs - x2 * sn; o2 = x1 * sn + x2 * cs; }
        if (g == 0) { if (lat) { o.RQ[(size_t)m * 512 + c1] = f2bf(o1); o.RQ[(size_t)m * 512 + c2] = f2bf(o2); } }
        else { const int tc = t & 127;
            for (int d = 0; d < 2; ++d) { const float lg = log_sigmoid(o.decay_logit[d * 4 + h]); const float dec = expf(lg * (float)(d == 0 ? 127 - tc : tc)) * RKSCALE;
                bf16_t* dst = o.RKD + (size_t)d * MTOT * 512 + (size_t)m * 512; dst[c1] = f2bf(o1 * dec); dst[c2] = f2bf(o2 * dec); } }
    } else if (g == 2) { o.RV[(size_t)m * 512 + c] = f2bf(pr[c]); o.RV[(size_t)m * 512 + 256 + c] = f2bf(pr[256 + c]);
    } else if (g == 3) { if (lat) { o.RG[(size_t)m * 512 + c] = f2bf(siluf(pr[c])); o.RG[(size_t)m * 512 + 256 + c] = f2bf(siluf(pr[256 + c])); }
    } else if (g == 4 || g == 5) {
        const int hh = c >> 5, j = c & 31, c1 = 64 * hh + j, c2 = c1 + 32;
        float x1 = pr[c1], x2 = pr[c2], o1 = x1, o2 = x2;
        if (lat) { const float cs = o.cosd[t * 32 + j], sn = o.sind[t * 32 + j]; o1 = x1 * cs - x2 * sn; o2 = x1 * sn + x2 * cs; }
        if (g == 4) { if (lat) { o.DQ[(size_t)m * 512 + c1] = f2bf(o1 * QSCALE); o.DQ[(size_t)m * 512 + c2] = f2bf(o2 * QSCALE); } }
        else { const int pos = lat ? 256 + t : t; bf16_t* dst = o.DK + ((size_t)b * KVL + pos) * 512; dst[c1] = f2bf(o1); dst[c2] = f2bf(o2); }
    } else { const int pos = lat ? 256 + t : t; bf16_t* dst = o.DV + ((size_t)b * KVL + pos) * 512; dst[c] = f2bf(pr[c]); dst[256 + c] = f2bf(pr[256 + c]); }
}
__global__ void __launch_bounds__(128) k_ret(const bf16_t* __restrict__ RQ, const bf16_t* __restrict__ RKD, const bf16_t* __restrict__ RV, const bf16_t* __restrict__ RG,
                                            const float* __restrict__ decay_logit, const float* __restrict__ gn_g, float* __restrict__ TMP, bf16_t* __restrict__ YA) {
    __shared__ float qs[128], ks[128], red[8];
    const int b = blockIdx.x >> 2, h = blockIdx.x & 3, e = threadIdx.x;
    for (int d = 0; d < 2; ++d) {
        const float lg = log_sigmoid(decay_logit[d * 4 + h]), gam = expf(lg);
        const float gg = gn_g[d * 512 + h * 128 + e];
        const bf16_t* KD = RKD + (size_t)d * MTOT * 512;
        float S[128];
#pragma unroll
        for (int i = 0; i < 128; ++i) S[i] = 0.f;
        for (int step = 0; step < KVL; ++step) {
            const bool isctx = step < CTXL; const int tt = isctx ? step : step - CTXL; const int L = isctx ? CTXL : SEQ;
            const int t = d == 0 ? tt : L - 1 - tt; const int m = isctx ? MLAT + b * CTXL + t : b * SEQ + t; const int tc = t & 127;
            const float undo = expf(-lg * (float)(d == 0 ? 127 - tc : tc));
            __syncthreads();
            ks[e] = bf2f(KD[(size_t)m * 512 + h * 128 + e]) * undo;
            qs[e] = isctx ? 0.f : bf2f(RQ[(size_t)m * 512 + h * 128 + e]);
            const float v = bf2f(RV[(size_t)m * 512 + h * 128 + e]);
            __syncthreads();
            float oo = 0.f;
#pragma unroll
            for (int i = 0; i < 128; ++i) { S[i] = gam * S[i] + ks[i] * v; oo += qs[i] * S[i]; }
            if (!isctx) {
                const float s1 = wave_sum(oo), s2 = wave_sum(oo * oo);
                if ((e & 63) == 0) { red[(e >> 6) * 2] = s1; red[(e >> 6) * 2 + 1] = s2; }
                __syncthreads();
                const float mu = (red[0] + red[2]) * (1.f / 128.f); const float var = (red[1] + red[3]) * (1.f / 128.f) - mu * mu;
                const float on = (oo - mu) * rsqrtf(var + GN_EPS) * gg;
                const size_t off = (size_t)m * 512 + h * 128 + e;
                if (d == 0) TMP[off] = on; else YA[(size_t)m * 1024 + h * 128 + e] = f2bf(bf2f(RG[off]) * (TMP[off] + on));
            }
        }
    }
}
__global__ void __launch_bounds__(256) k_attn(const bf16_t* __restrict__ DQ, const bf16_t* __restrict__ DK, const bf16_t* __restrict__ DV, const float* __restrict__ subln_g, const float* __restrict__ MISC, bf16_t* __restrict__ YA) {
    const int tid = threadIdx.x, qi = tid >> 2, mp = (tid >> 1) & 1, hf = tid & 1;
    const int h = blockIdx.y, m = blockIdx.x * 64 + qi, b = m >> 12;
    float q[64];
    const bf16_t* qp = DQ + (size_t)m * 512 + h * 128 + mp * 64;
#pragma unroll
    for (int i = 0; i < 64; ++i) q[i] = bf2f(qp[i]);
    float o[64];
#pragma unroll
    for (int i = 0; i < 64; ++i) o[i] = 0.f;
    float mx = -1e30f, l = 0.f;
    const bf16_t* kb = DK + (size_t)b * KVL * 512 + h * 128 + mp * 64;
    const bf16_t* vb = DV + (size_t)b * KVL * 512 + h * 128 + hf * 64;
    for (int j = 0; j < KVL; ++j) {
        const bf16_t* kr = kb + (size_t)j * 512; const bf16_t* vr = vb + (size_t)j * 512;
        float s = 0.f;
#pragma unroll
        for (int i = 0; i < 64; i += 8) { const u32x4 w = *(const u32x4*)(kr + i);
            s += q[i] * __uint_as_float(w.x << 16) + q[i + 1] * __uint_as_float(w.x & 0xffff0000u) + q[i + 2] * __uint_as_float(w.y << 16) + q[i + 3] * __uint_as_float(w.y & 0xffff0000u)
               + q[i + 4] * __uint_as_float(w.z << 16) + q[i + 5] * __uint_as_float(w.z & 0xffff0000u) + q[i + 6] * __uint_as_float(w.w << 16) + q[i + 7] * __uint_as_float(w.w & 0xffff0000u); }
        if (s > mx) { const float a = exp2f(mx - s); l *= a;
#pragma unroll
            for (int i = 0; i < 64; ++i) o[i] *= a;
            mx = s; }
        const float p = exp2f(s - mx); l += p;
#pragma unroll
        for (int i = 0; i < 64; i += 8) { const u32x4 w = *(const u32x4*)(vr + i);
            o[i] += p * __uint_as_float(w.x << 16); o[i + 1] += p * __uint_as_float(w.x & 0xffff0000u); o[i + 2] += p * __uint_as_float(w.y << 16); o[i + 3] += p * __uint_as_float(w.y & 0xffff0000u);
            o[i + 4] += p * __uint_as_float(w.z << 16); o[i + 5] += p * __uint_as_float(w.z & 0xffff0000u); o[i + 6] += p * __uint_as_float(w.w << 16); o[i + 7] += p * __uint_as_float(w.w & 0xffff0000u); }
    }
    const float lam = MISC[0], rl = 1.f / l; float ss = 0.f;
#pragma unroll
    for (int i = 0; i < 64; ++i) { const float mine = o[i] * rl, other = __shfl_xor(mine, 2); const float dd = mp == 0 ? mine - lam * other : other - lam * mine; o[i] = dd; ss += dd * dd; }
    ss += __shfl_xor(ss, 1);
    const float rs = rsqrtf(ss * (1.f / 128.f) + EPS) * (1.f - LAMBDA_INIT);
    if (mp == 0) { bf16_t* yo = YA + (size_t)m * 1024 + 512 + h * 128 + hf * 64; const float* gg = subln_g + h * 128 + hf * 64;
#pragma unroll
        for (int i = 0; i < 64; ++i) yo[i] = f2bf(o[i] * rs * gg[i]); }
}
__global__ void __launch_bounds__(256) k_post_wout(const float* __restrict__ ACC, const float* __restrict__ x, const float* __restrict__ MOD, const float* __restrict__ GAM2, float* __restrict__ OUT, bf16_t* __restrict__ A2, float* __restrict__ rowss) {
    const int lane = threadIdx.x & 63, m = blockIdx.x * 4 + (threadIdx.x >> 6), b = m >> 12; float s = 0.f;
#pragma unroll
    for (int j = 0; j < 4; ++j) { const int k = 4 * lane + 256 * j; const f32x4 a = *(const f32x4*)(ACC + (size_t)m * D + k), xv = *(const f32x4*)(x + (size_t)m * D + k), g1 = *(const f32x4*)(MOD + b * NMOD + 2 * D + k), g2 = *(const f32x4*)(GAM2 + b * D + k);
        const f32x4 x1 = xv + g1 * a; *(f32x4*)(OUT + (size_t)m * D + k) = x1; s += x1.x * x1.x + x1.y * x1.y + x1.z * x1.z + x1.w * x1.w; const f32x4 hq = x1 * g2;
        u32x2 w; w.x = f2bf(hq.x) | ((unsigned)f2bf(hq.y) << 16); w.y = f2bf(hq.z) | ((unsigned)f2bf(hq.w) << 16); *(u32x2*)(A2 + (size_t)m * D + k) = w; }
    s = wave_sum(s); if (lane == 0) rowss[m] = s;
}
__global__ void __launch_bounds__(256) k_post_up(const float* __restrict__ ACC, int n0, int row0, const float* __restrict__ rowss, const float* __restrict__ BIAS2, bf16_t* __restrict__ UH) {
    const int r = blockIdx.x, m = row0 + r, b = m >> 12; const float rstd = rsqrtf(rowss[m] * (1.f / D) + EPS);
    for (int c = threadIdx.x; c < 512; c += 256) UH[(size_t)r * DFF2 + n0 + c] = f2bf(rstd * ACC[(size_t)r * 512 + c] + BIAS2[b * DFF2 + n0 + c]);
}
__global__ void __launch_bounds__(256) k_conv(const bf16_t* __restrict__ UH, int row0, const float* __restrict__ conv_w, const float* __restrict__ conv_b, bf16_t* __restrict__ G) {
    const int r = blockIdx.x, m = row0 + r, t = m & 4095;
    for (int j = threadIdx.x; j < DFF; j += 256) {
        float ca = conv_b[j], cb = conv_b[DFF + j];
        if (t > 0)    { ca += conv_w[j] * bf2f(UH[(size_t)(r - 1) * DFF2 + j]);            cb += conv_w[DFF + j] * bf2f(UH[(size_t)(r - 1) * DFF2 + DFF + j]); }
                      { ca += conv_w[DFF2 + j] * bf2f(UH[(size_t)r * DFF2 + j]);           cb += conv_w[DFF2 + DFF + j] * bf2f(UH[(size_t)r * DFF2 + DFF + j]); }
        if (t < 4095) { ca += conv_w[2 * DFF2 + j] * bf2f(UH[(size_t)(r + 1) * DFF2 + j]); cb += conv_w[2 * DFF2 + DFF + j] * bf2f(UH[(size_t)(r + 1) * DFF2 + DFF + j]); }
        G[(size_t)m * DFF + j] = f2bf(siluf(ca) * cb);
    }
}
__global__ void __launch_bounds__(256) k_post_down(const float* __restrict__ ACC, const float* __restrict__ MOD, const float* __restrict__ final_g, float* __restrict__ OUT) {
    const int lane = threadIdx.x & 63, m = blockIdx.x * 4 + (threadIdx.x >> 6), b = m >> 12; float s = 0.f; f32x4 v[4];
#pragma unroll
    for (int j = 0; j < 4; ++j) { const int k = 4 * lane + 256 * j; const f32x4 a = *(const f32x4*)(ACC + (size_t)m * D + k), x1 = *(const f32x4*)(OUT + (size_t)m * D + k), g2 = *(const f32x4*)(MOD + b * NMOD + 5 * D + k);
        v[j] = x1 + g2 * a; s += v[j].x * v[j].x + v[j].y * v[j].y + v[j].z * v[j].z + v[j].w * v[j].w; }
    const float rstd = rsqrtf(wave_sum(s) * (1.f / D) + EPS);
#pragma unroll
    for (int j = 0; j < 4; ++j) { const int k = 4 * lane + 256 * j; *(f32x4*)(OUT + (size_t)m * D + k) = v[j] * rstd * *(const f32x4*)(final_g + k); }
}
}
namespace pg8 {
#define PG8_LAS __attribute__((address_space(3)))
typedef unsigned short bf16_t;
typedef short bf16x8 __attribute__((ext_vector_type(8)));
typedef float f32x4 __attribute__((ext_vector_type(4)));
typedef unsigned u32x4 __attribute__((ext_vector_type(4)));
constexpr int BM = 256, BK = 64, HALF = 128, HTB = HALF * BK * 2  , STAGE_BYTES = 8 * HTB, NXCD = 8, WGM = 8;

__host__ __device__ __forceinline__ int lds_byte(int r, int c) { const int st = (r >> 4) * 2 + (c >> 5), rr = r & 15, cc = c & 31, ob = rr * 64 + cc * 2; return st * 1024 + (ob ^ (((ob >> 9) & 1) << 5)); }
__host__ __device__ __forceinline__ void stage_rc(int b, int& R, int& C) { const int st = b / 1024, sb = b % 1024, swz = sb ^ (((sb >> 9) & 1) << 5); R = (st >> 1) * 16 + swz / 64; C = (st & 1) * 32 + (swz % 64) / 2; }
__host__ __device__ __forceinline__ int perm32(int rho) { const int n = rho >> 4, i = rho & 15; return 8 * (i >> 2) + 4 * n + (i & 3); }

struct Unit { int pm, pn; };
struct Gemm { const bf16_t* A; const bf16_t* Bt; int M, N, K; };

struct StaticOrder {
    int nM, nN, nwg, G, c;
    __host__ __device__ void init(int M, int N, int G_, int c_) { nM = M / BM; nN = N / BM; nwg = nM * nN; G = G_; c = c_; }
    __host__ __device__ bool next(int i, Unit& u) const {
        const long L = (long)i * G + c; if (L >= nwg) return false;
        int wgid = (int)L; { const int q = nwg / NXCD, r = nwg % NXCD, xcd = wgid % NXCD, off = wgid / NXCD; wgid = (xcd < r ? xcd * (q + 1) : r * (q + 1) + (xcd - r) * q) + off; }
        const int nig = WGM * nN, gid = wgid / nig, fm = gid * WGM, gsz = (nM - fm) < WGM ? (nM - fm) : WGM;
        u.pm = fm + ((wgid % nig) % gsz); u.pn = (wgid % nig) / gsz; return true;
    }
    __device__ __forceinline__ void a_ready(const Unit&) const {}
    __device__ __forceinline__ void done(const Unit&) const {}
};

__device__ __forceinline__ unsigned cvt_pk_bf16(float lo, float hi) { unsigned r; asm volatile("v_cvt_pk_bf16_f32 %0, %1, %2" : "=v"(r) : "v"(lo), "v"(hi)); return r; }
template <class Epi, class Sched, bool ALIGN_EPI = false, bool SP2 = false>
__device__ __forceinline__ void gemm_phase(PG8_LAS unsigned char* lds, const Gemm g, const Sched& S, const Epi& E, int wid_in) {
    const int wid = wid_in, lane = lane_now(), tid = wid * 64 + lane, wr = wid >> 2, wc = wid & 3, fr = lane & 15, fq = lane >> 4;
    const int K = g.K, nt = K / BK;
    unsigned voffA[2], voffB[2];
#pragma unroll
    for (int i = 0; i < 2; ++i) { int R, C; stage_rc(tid * 16 + i * 8192, R, C); const int Rb = Epi::PERM ? ((R & ~31) + perm32(R & 31)) : R;
        voffA[i] = (unsigned)(R * K + C) * 2u; voffB[i] = (unsigned)(Rb * K + C) * 2u; }
    const size_t kstep = (size_t)(BK * 2);
    const size_t hstep = (size_t)HALF * K * 2;
    const size_t tstep = 2 * hstep;
    const unsigned ldsw = (unsigned)wid * 1024u;
    const int aoff = lds_byte(wr * 64 + fr, fq * 8), boff = lds_byte(wc * 32 + fr, fq * 8);
#define PG8_SA(b, h) (((b) * 2 + (h)) * HTB)
#define PG8_SB(b, h) ((4 + (b) * 2 + (h)) * HTB)
#define PG8_STAGE(bufoff, gbase, voff) do { _Pragma("unroll") for (int _i = 0; _i < 2; ++_i) \
        __builtin_amdgcn_global_load_lds((const unsigned*)((const char*)(gbase) + (voff)[_i]), (PG8_LAS unsigned*)(lds + (bufoff) + ldsw + _i * 8192), 16, 0, 0); } while (0)
#define PG8_LDA(dst, b, h) do { _Pragma("unroll") for (int m = 0; m < 4; ++m) _Pragma("unroll") for (int k = 0; k < 2; ++k) dst[m][k] = *(const PG8_LAS bf16x8*)(lds + PG8_SA(b, h) + aoff + m * 2048 + k * 1024); } while (0)
#define PG8_LDB(dst, b, h) do { _Pragma("unroll") for (int n = 0; n < 2; ++n) _Pragma("unroll") for (int k = 0; k < 2; ++k) dst[n][k] = *(const PG8_LAS bf16x8*)(lds + PG8_SB(b, h) + boff + n * 2048 + k * 1024); } while (0)
#define PG8_MMA(ai, bj, At, Bt) do { __builtin_amdgcn_s_setprio(1); _Pragma("unroll") for (int m = 0; m < 4; ++m) _Pragma("unroll") for (int n = 0; n < 2; ++n) _Pragma("unroll") for (int k = 0; k < 2; ++k) \
        acc[ai][bj][m][n] = __builtin_amdgcn_mfma_f32_16x16x32_bf16(Bt[n][k], At[m][k], acc[ai][bj][m][n], 0, 0, 0); __builtin_amdgcn_s_setprio(0); } while (0)
#define PG8_WAIT_V(n) asm volatile("s_waitcnt vmcnt(" #n ")" ::: "memory")
#define PG8_WAIT_L(n) asm volatile("s_waitcnt lgkmcnt(" #n ")" ::: "memory")
#define PG8_BAR __builtin_amdgcn_s_barrier()
#define PG8_SCHED __builtin_amdgcn_sched_barrier(0)
    Unit cur, nxt; int ui = 0;
    if (!S.next(0, cur)) return;
    f32x4 acc[2][2][4][2];
#pragma unroll
    for (int a = 0; a < 2; ++a)
#pragma unroll
        for (int b = 0; b < 2; ++b)
#pragma unroll
            for (int m = 0; m < 4; ++m)
#pragma unroll
                for (int n = 0; n < 2; ++n) acc[a][b][m][n] = (f32x4){0.f, 0.f, 0.f, 0.f};
    bf16x8 At[4][2], B0[2][2], B1[2][2];
    const char* cA = (const char*)g.A + (size_t)cur.pm * tstep; const char* cB = (const char*)g.Bt + (size_t)cur.pn * tstep;
    S.a_ready(cur);
    if constexpr (SP2) {
        PG8_STAGE(PG8_SB(0, 0), cB, voffB); PG8_STAGE(PG8_SB(0, 1), cB + hstep, voffB); PG8_STAGE(PG8_SA(0, 0), cA, voffA); PG8_STAGE(PG8_SA(0, 1), cA + hstep, voffA);
        if (wr == 1) PG8_BAR;
        PG8_WAIT_V(2); PG8_BAR;
        PG8_STAGE(PG8_SB(1, 0), cB + kstep, voffB); PG8_STAGE(PG8_SA(1, 0), cA + kstep, voffA); PG8_STAGE(PG8_SB(1, 1), cB + hstep + kstep, voffB);
        PG8_WAIT_V(6); PG8_BAR;
    } else {
        PG8_STAGE(PG8_SB(0, 0), cB, voffB); PG8_STAGE(PG8_SA(0, 0), cA, voffA); PG8_STAGE(PG8_SB(0, 1), cB + hstep, voffB); PG8_STAGE(PG8_SA(0, 1), cA + hstep, voffA);
        if (wr == 1) PG8_BAR;
        PG8_WAIT_V(4); PG8_BAR;
        PG8_STAGE(PG8_SB(1, 0), cB + kstep, voffB); PG8_STAGE(PG8_SA(1, 0), cA + kstep, voffA); PG8_STAGE(PG8_SB(1, 1), cB + hstep + kstep, voffB);
        PG8_WAIT_V(6); PG8_BAR;
    }
    for (;;) {
        const bool has_next = S.next(ui + 1, nxt);
        const char* nA = has_next ? (const char*)g.A + (size_t)nxt.pm * tstep : cA; const char* nB = has_next ? (const char*)g.Bt + (size_t)nxt.pn * tstep : cB;
        for (int t = 0; t < nt; t += 2) {
            const bool last = (t == nt - 2);
            const char* a1 = cA + (size_t)(t + 1) * kstep;
            const char* a2 = last ? nA : cA + (size_t)(t + 2) * kstep; const char* b2 = last ? nB : cB + (size_t)(t + 2) * kstep;
            const char* a3 = a2 + kstep; const char* b3 = b2 + kstep;
            if (last && has_next) S.a_ready(nxt);
            if constexpr (SP2) {
            PG8_LDB(B0, 0, 0); PG8_LDB(B1, 0, 1); PG8_SCHED; PG8_LDA(At, 0, 0); PG8_STAGE(PG8_SA(1, 1), a1 + hstep, voffA);
            PG8_WAIT_V(8); PG8_WAIT_L(0); PG8_BAR; PG8_MMA(0, 0, At, B0); PG8_MMA(0, 1, At, B1); PG8_BAR; PG8_SCHED;
            PG8_LDA(At, 0, 1); PG8_STAGE(PG8_SB(0, 0), b2, voffB); PG8_STAGE(PG8_SB(0, 1), b2 + hstep, voffB); PG8_STAGE(PG8_SA(0, 0), a2, voffA);
            PG8_WAIT_V(8); PG8_WAIT_L(0); PG8_BAR; PG8_MMA(1, 0, At, B0); PG8_MMA(1, 1, At, B1); PG8_BAR; PG8_SCHED;
            PG8_LDB(B0, 1, 0); PG8_LDB(B1, 1, 1); PG8_SCHED; PG8_LDA(At, 1, 0); PG8_STAGE(PG8_SA(0, 1), a2 + hstep, voffA);
            PG8_WAIT_V(8); PG8_WAIT_L(0); PG8_BAR; PG8_MMA(0, 0, At, B0); PG8_MMA(0, 1, At, B1); PG8_BAR; PG8_SCHED;
            PG8_LDA(At, 1, 1); PG8_STAGE(PG8_SB(1, 0), b3, voffB); PG8_STAGE(PG8_SB(1, 1), b3 + hstep, voffB); PG8_STAGE(PG8_SA(1, 0), a3, voffA);
            PG8_WAIT_V(8); PG8_WAIT_L(0); PG8_BAR; PG8_MMA(1, 0, At, B0); PG8_MMA(1, 1, At, B1); PG8_BAR; PG8_SCHED;
            } else {
            PG8_LDB(B0, 0, 0); PG8_SCHED; PG8_LDA(At, 0, 0); PG8_STAGE(PG8_SA(1, 1), a1 + hstep, voffA);
            PG8_WAIT_L(8); PG8_BAR; PG8_WAIT_L(0); PG8_MMA(0, 0, At, B0); PG8_BAR; PG8_SCHED;
            PG8_LDB(B1, 0, 1); PG8_STAGE(PG8_SB(0, 0), b2, voffB);
            PG8_BAR; PG8_WAIT_L(0); PG8_MMA(0, 1, At, B1); PG8_BAR;
            PG8_LDA(At, 0, 1); PG8_STAGE(PG8_SA(0, 0), a2, voffA);
            PG8_BAR; PG8_WAIT_L(0); PG8_MMA(1, 0, At, B0); PG8_BAR; PG8_SCHED;
            PG8_STAGE(PG8_SB(0, 1), b2 + hstep, voffB);
            PG8_WAIT_V(6); PG8_BAR; PG8_MMA(1, 1, At, B1); PG8_BAR;
            PG8_LDB(B0, 1, 0); PG8_SCHED; PG8_LDA(At, 1, 0); PG8_STAGE(PG8_SA(0, 1), a2 + hstep, voffA);
            PG8_WAIT_L(8); PG8_BAR; PG8_WAIT_L(0); PG8_MMA(0, 0, At, B0); PG8_BAR; PG8_SCHED;
            PG8_LDB(B1, 1, 1); PG8_STAGE(PG8_SB(1, 0), b3, voffB);
            PG8_BAR; PG8_WAIT_L(0); PG8_MMA(0, 1, At, B1); PG8_BAR;
            PG8_LDA(At, 1, 1); PG8_STAGE(PG8_SA(1, 0), a3, voffA);
            PG8_BAR; PG8_WAIT_L(0); PG8_MMA(1, 0, At, B0); PG8_BAR; PG8_SCHED;
            PG8_STAGE(PG8_SB(1, 1), b3 + hstep, voffB);
            PG8_WAIT_V(6); PG8_BAR; PG8_MMA(1, 1, At, B1); PG8_BAR;
            }
        }
        if constexpr (ALIGN_EPI) { if (wr == 0) PG8_BAR; }
        if constexpr (!Epi::AFTER_DRAIN) { E(acc, cur, wr, wc, fr, fq); S.done(cur); }
        if (!has_next) break;
#pragma unroll
        for (int a = 0; a < 2; ++a)
#pragma unroll
            for (int b = 0; b < 2; ++b)
#pragma unroll
                for (int m = 0; m < 4; ++m)
#pragma unroll
                    for (int n = 0; n < 2; ++n) acc[a][b][m][n] = (f32x4){0.f, 0.f, 0.f, 0.f};
        cur = nxt; cA = nA; cB = nB; ++ui;
        if constexpr (ALIGN_EPI) { if (wr == 1) PG8_BAR; }
    }
    PG8_WAIT_V(0);
    if constexpr (!ALIGN_EPI) { if (wr == 0) PG8_BAR; }
    PG8_BAR;
    if constexpr (Epi::AFTER_DRAIN) { E.fused(acc, cur, wr, wc, fr, fq, lds, wid, lane); S.done(cur); }
#undef PG8_SA
#undef PG8_SB
#undef PG8_STAGE
#undef PG8_LDA
#undef PG8_LDB
#undef PG8_MMA
#undef PG8_WAIT_V
#undef PG8_WAIT_L
#undef PG8_BAR
#undef PG8_SCHED
}
}
namespace da {
using bf16x8 = __attribute__((ext_vector_type(8))) short;
using s16x4  = __attribute__((ext_vector_type(4))) short;
using f32x16 = __attribute__((ext_vector_type(16))) float;
constexpr int KVBLK = 64, LDK = 512, NT = KVL / KVBLK;
constexpr int SHM_V = KVBLK * 128 * 2, SHM_K = KVBLK * 128 * 2, SHM_ATTN = 2 * SHM_V + 2 * SHM_K + 8 * 64 * 4;
constexpr float THRL = 8.f;
static_assert(NT % 2 == 0, "even tile count");
#define DA_KSWZ(row, colB) ((row) * 256 + ((colB) ^ (((row) & 7) << 4)))
#define DA_SBAR() __builtin_amdgcn_sched_barrier(0)
__device__ __forceinline__ int crow(int r, int hi) { return (r & 3) + 8 * (r >> 2) + 4 * hi; }
__device__ __forceinline__ unsigned cvtpk(float lo, float hi) { unsigned r; asm volatile("v_cvt_pk_bf16_f32 %0, %1, %2" : "=v"(r) : "v"(lo), "v"(hi)); return r; }

__device__ __forceinline__ void partialSM(f32x16& p0, f32x16& p1, float& m_reg, float& mn, float& alpha) {
  float pmax = p0[0];
#pragma unroll
  for (int r = 1; r < 16; ++r) pmax = fmaxf(pmax, p0[r]);
#pragma unroll
  for (int r = 0; r < 16; ++r) pmax = fmaxf(pmax, p1[r]);
  { auto rr = __builtin_amdgcn_permlane32_swap(__float_as_uint(pmax), __float_as_uint(pmax), false, false);
    pmax = fmaxf(__uint_as_float(rr[0]), __uint_as_float(rr[1])); }
  if (__builtin_expect(__all(pmax - m_reg <= THRL), 1)) { mn = m_reg; alpha = 1.f; }
  else { mn = fmaxf(m_reg, pmax); alpha = __builtin_amdgcn_exp2f(m_reg - mn); m_reg = mn; }
#pragma unroll
  for (int r = 0; r < 16; ++r) { p0[r] = p0[r] - mn; p1[r] = p1[r] - mn; }
#pragma unroll
  for (int r = 0; r < 16; ++r) p0[r] = __builtin_amdgcn_exp2f(p0[r]);
}
__device__ __forceinline__ void finishSM(f32x16& p0, f32x16& p1, float alpha, float& l_reg, bf16x8& pa0, bf16x8& pa1, bf16x8& pa2, bf16x8& pa3) {
#pragma unroll
  for (int r = 0; r < 16; ++r) p1[r] = __builtin_amdgcn_exp2f(p1[r]);
  float ps = 0;
#pragma unroll
  for (int r = 0; r < 16; ++r) ps += p0[r];
#pragma unroll
  for (int r = 0; r < 16; ++r) ps += p1[r];
  { auto rr = __builtin_amdgcn_permlane32_swap(__float_as_uint(ps), __float_as_uint(ps), false, false);
    ps = __uint_as_float(rr[0]) + __uint_as_float(rr[1]); }
  l_reg = l_reg * alpha + ps;
#define DA_PK4(P, BASE, OUT) do { unsigned a0 = cvtpk(P[BASE + 0], P[BASE + 1]), a1 = cvtpk(P[BASE + 2], P[BASE + 3]);   \
    unsigned b0 = cvtpk(P[BASE + 4], P[BASE + 5]), b1 = cvtpk(P[BASE + 6], P[BASE + 7]);                              \
    auto r0 = __builtin_amdgcn_permlane32_swap(a0, b0, false, false); auto r1 = __builtin_amdgcn_permlane32_swap(a1, b1, false, false); \
    u32x4 w = {r0[0], r1[0], r0[1], r1[1]}; OUT = *reinterpret_cast<bf16x8*>(&w); } while (0)
  DA_PK4(p0, 0, pa0); DA_PK4(p0, 8, pa1); DA_PK4(p1, 0, pa2); DA_PK4(p1, 8, pa3);
#undef DA_PK4
}
__device__ __forceinline__ void qkt(f32x16& p0, f32x16& p1, const char* Ks, const bf16x8* qr, int r32, int hi, int mp) {
  p0 = f32x16{}; p1 = f32x16{};
#pragma unroll
  for (int d0 = 0; d0 < 4; ++d0) { const int cb = (mp * 64 + d0 * 16 + hi * 8) * 2;
    bf16x8 b0 = *reinterpret_cast<const bf16x8*>(Ks + DA_KSWZ(r32, cb));
    bf16x8 b1 = *reinterpret_cast<const bf16x8*>(Ks + DA_KSWZ(32 + r32, cb));
    p0 = __builtin_amdgcn_mfma_f32_32x32x16_bf16(b0, qr[d0], p0, 0, 0, 0);
    p1 = __builtin_amdgcn_mfma_f32_32x32x16_bf16(b1, qr[d0], p1, 0, 0, 0); }
}
__device__ __forceinline__ int v_st(int k, int c) { const int kk = (k & ~0xC) | ((k & 4) << 1) | ((k & 8) >> 1); return ((kk >> 3) * 4 + (c >> 5)) * 512 + ((kk & 7) * 32 + (c & 31)) * 2; }
__device__ __forceinline__ int v_rd_base(int lane) { return ((lane & 3) << 3) | (((lane >> 2) & 3) << 6) | (((lane >> 4) & 1) << 5) | (((lane >> 5) & 1) << 8); }
constexpr int v_rd_off(int d0, int ks, int half) { return d0 * 512 + ks * 4096 + half * 2048; }
template <int OFF> __device__ __forceinline__ s16x4 tr_read(int vb) {
  s16x4 r; asm volatile("ds_read_b64_tr_b16 %0, %1 offset:%2" : "=&v"(r) : "v"(vb), "i"(OFF) : "memory"); return r;
}
template <int D0> __device__ __forceinline__ void pv_one(f32x16& od, int vb, bf16x8 pa0, bf16x8 pa1, bf16x8 pa2, bf16x8 pa3) {
  const s16x4 l0 = tr_read<v_rd_off(D0, 0, 0)>(vb), h0 = tr_read<v_rd_off(D0, 0, 1)>(vb), l1 = tr_read<v_rd_off(D0, 1, 0)>(vb), h1 = tr_read<v_rd_off(D0, 1, 1)>(vb);
  const s16x4 l2 = tr_read<v_rd_off(D0, 2, 0)>(vb), h2 = tr_read<v_rd_off(D0, 2, 1)>(vb), l3 = tr_read<v_rd_off(D0, 3, 0)>(vb), h3 = tr_read<v_rd_off(D0, 3, 1)>(vb);
  asm volatile("s_waitcnt lgkmcnt(0)" ::: "memory"); DA_SBAR();
#define DA_PK(L, H) (bf16x8){L[0], L[1], L[2], L[3], H[0], H[1], H[2], H[3]}
  od = __builtin_amdgcn_mfma_f32_32x32x16_bf16(pa0, DA_PK(l0, h0), od, 0, 0, 0);
  od = __builtin_amdgcn_mfma_f32_32x32x16_bf16(pa1, DA_PK(l1, h1), od, 0, 0, 0);
  od = __builtin_amdgcn_mfma_f32_32x32x16_bf16(pa2, DA_PK(l2, h2), od, 0, 0, 0);
  od = __builtin_amdgcn_mfma_f32_32x32x16_bf16(pa3, DA_PK(l3, h3), od, 0, 0, 0);
#undef DA_PK
}
__device__ __forceinline__ void pv_d0(f32x16* o, int vb, bf16x8 pa0, bf16x8 pa1, bf16x8 pa2, bf16x8 pa3) {
  pv_one<0>(o[0], vb, pa0, pa1, pa2, pa3); pv_one<1>(o[1], vb, pa0, pa1, pa2, pa3); pv_one<2>(o[2], vb, pa0, pa1, pa2, pa3); pv_one<3>(o[3], vb, pa0, pa1, pa2, pa3);
}

__device__ __forceinline__ void attn_unit(const bf16_t* __restrict__ Qb, const bf16_t* __restrict__ Kh, const bf16_t* __restrict__ Vh, bf16_t* __restrict__ Yb,
                                          const float* __restrict__ gsub, float lam, char* lds, int wid) {
  const int lane = lane_now(), tid = wid * 64 + lane, r32 = lane & 31, hi = lane >> 5, mp = wid >> 2, wq = wid & 3;
  char* V_lds = lds; char* K_lds = lds + 2 * SHM_V;
  float* wsf = (float*)(lds + 2 * SHM_V + 2 * SHM_K) + wid * 64; float* li_l = wsf; float* al_l = wsf + 32;
  float m_reg = -1e30f, l_reg = 0; f32x16 o[4] = {}; bf16x8 qr[4];
  const bf16_t* Qw = Qb + (long)(wq * 32 + r32) * 512 + mp * 64 + hi * 8;
#pragma unroll
  for (int d0 = 0; d0 < 4; ++d0) qr[d0] = *reinterpret_cast<const bf16x8*>(Qw + d0 * 16);
  const int sr = tid >> 4, sc = (tid & 15) * 8, vst0 = v_st(sr, sc), vst1 = v_st(32 + sr, sc);
  const int vb0 = (int)(uintptr_t)V_lds + v_rd_base(lane);
  struct { bf16x8 vs0, vs1, ks0, ks1; } sr_[2];
#define SLOAD(i, k0) do { sr_[i].vs0 = *reinterpret_cast<const bf16x8*>(&Vh[(long)((k0) + sr) * LDK + sc]); sr_[i].vs1 = *reinterpret_cast<const bf16x8*>(&Vh[(long)((k0) + 32 + sr) * LDK + sc]); \
    sr_[i].ks0 = *reinterpret_cast<const bf16x8*>(&Kh[(long)((k0) + sr) * LDK + sc]); sr_[i].ks1 = *reinterpret_cast<const bf16x8*>(&Kh[(long)((k0) + 32 + sr) * LDK + sc]); } while (0)
#define SWRITE(b, i) do { *(bf16x8*)(V_lds + (b) * SHM_V + vst0) = sr_[i].vs0; *(bf16x8*)(V_lds + (b) * SHM_V + vst1) = sr_[i].vs1; const int kc = sc * 2; \
    *(bf16x8*)(K_lds + (b) * SHM_K + DA_KSWZ(sr, kc)) = sr_[i].ks0; *(bf16x8*)(K_lds + (b) * SHM_K + DA_KSWZ(32 + sr, kc)) = sr_[i].ks1; } while (0)
#define SWAIT() asm volatile("s_waitcnt vmcnt(4)" ::: "memory")
#define RESC(a) do { if (__any((a) < 1.f)) { if (hi == 0) al_l[r32] = (a); asm volatile("s_waitcnt lgkmcnt(0)" ::: "memory"); \
    _Pragma("unroll") for (int d = 0; d < 4; ++d) _Pragma("unroll") for (int r = 0; r < 16; ++r) o[d][r] *= al_l[crow(r, hi)]; } } while (0)
  f32x16 pA0, pA1, pB0, pB1; float mnA, mnB, alA, alB; bf16x8 pa0, pa1, pa2, pa3;
  constexpr int SE = 0, SO = 1;
  SLOAD(SE, 0); asm volatile("s_waitcnt vmcnt(0)" ::: "memory"); SWRITE(0, SE); __syncthreads();
  qkt(pA0, pA1, K_lds, qr, r32, hi, mp); partialSM(pA0, pA1, m_reg, mnA, alA);
  SLOAD(SO, KVBLK); SLOAD(SE, 2 * KVBLK);
  SWAIT(); SWRITE(1, SO); __syncthreads();
  for (int j = 1; j + 1 < NT; j += 2) {
    DA_SBAR(); qkt(pB0, pB1, K_lds + SHM_K, qr, r32, hi, mp);
    finishSM(pA0, pA1, alA, l_reg, pa0, pa1, pa2, pa3); DA_SBAR();
    SLOAD(SO, (j + 2) * KVBLK); DA_SBAR();
    pv_d0(o, vb0, pa0, pa1, pa2, pa3); partialSM(pB0, pB1, m_reg, mnB, alB);
    __syncthreads(); SWAIT(); SWRITE(0, SE);
    RESC(alB); __syncthreads();
    DA_SBAR(); qkt(pA0, pA1, K_lds, qr, r32, hi, mp);
    finishSM(pB0, pB1, alB, l_reg, pa0, pa1, pa2, pa3); DA_SBAR();
    if (j + 3 < NT) SLOAD(SE, (j + 3) * KVBLK); DA_SBAR();
    pv_d0(o, vb0 + SHM_V, pa0, pa1, pa2, pa3); partialSM(pA0, pA1, m_reg, mnA, alA);
    __syncthreads(); SWAIT(); SWRITE(1, SO);
    RESC(alA); __syncthreads();
  }
  DA_SBAR(); qkt(pB0, pB1, K_lds + SHM_K, qr, r32, hi, mp);
  finishSM(pA0, pA1, alA, l_reg, pa0, pa1, pa2, pa3); DA_SBAR();
  pv_d0(o, vb0, pa0, pa1, pa2, pa3); partialSM(pB0, pB1, m_reg, mnB, alB);
  __syncthreads(); RESC(alB);
  finishSM(pB0, pB1, alB, l_reg, pa0, pa1, pa2, pa3); DA_SBAR();
  pv_d0(o, vb0 + SHM_V, pa0, pa1, pa2, pa3);
  if (hi == 0) li_l[r32] = l_reg; asm volatile("s_waitcnt lgkmcnt(0)" ::: "memory");
  float rli[16];
#pragma unroll
  for (int r = 0; r < 16; ++r) rli[r] = __builtin_amdgcn_rcpf(li_l[crow(r, hi)]);
  __syncthreads();
  float* xch = (float*)lds;
  if (mp == 1) {
#pragma unroll
    for (int d0 = 0; d0 < 4; ++d0)
#pragma unroll
      for (int r = 0; r < 16; ++r) xch[((wq * 4 + d0) * 16 + r) * 64 + lane] = o[d0][r] * rli[r];
  }
  __syncthreads();
  if (mp == 0) {
    float ssq[16];
#pragma unroll
    for (int r = 0; r < 16; ++r) ssq[r] = 0.f;
#pragma unroll
    for (int d0 = 0; d0 < 4; ++d0)
#pragma unroll
      for (int r = 0; r < 16; ++r) { const float o1 = xch[((wq * 4 + d0) * 16 + r) * 64 + lane]; const float dd = o[d0][r] * rli[r] - lam * o1; o[d0][r] = dd; ssq[r] += dd * dd; }
#pragma unroll
    for (int r = 0; r < 16; ++r) {
#pragma unroll
      for (int off = 1; off < 32; off <<= 1) ssq[r] += __shfl_xor(ssq[r], off);
    }
    float gv[4];
#pragma unroll
    for (int d0 = 0; d0 < 4; ++d0) gv[d0] = gsub[d0 * 32 + r32] * (1.f - LAMBDA_INIT);
#pragma unroll
    for (int r = 0; r < 16; ++r) { const float rs = rsqrtf(ssq[r] * (1.f / 128.f) + EPS); bf16_t* yr = Yb + (long)(wq * 32 + crow(r, hi)) * 1024 + r32;
#pragma unroll
      for (int d0 = 0; d0 < 4; ++d0) yr[d0 * 32] = f2bf(o[d0][r] * rs * gv[d0]); }
  }
  __syncthreads();
#undef SLOAD
#undef SWRITE
#undef SWAIT
#undef RESC
}
#undef DA_KSWZ
#undef DA_SBAR
}
namespace rt {
#define RLAS __attribute__((address_space(3)))
using bf16x8 = __attribute__((ext_vector_type(8))) short;
using s16x4  = __attribute__((ext_vector_type(4))) short;
using f32x16 = __attribute__((ext_vector_type(16))) float;
typedef short v4i16_t __attribute__((ext_vector_type(4)));
typedef float f32x2 __attribute__((ext_vector_type(2)));
constexpr int TILEB = 32768, NSEG = 8, SEGC = 4, NSLOT = 8;
constexpr int T_Q = 0, T_K = TILEB, T_V = 2 * TILEB, T_S = 3 * TILEB;
constexpr size_t E_UNIT = 32 * 512;

__device__ __forceinline__ int crow(int r, int hi) { return (r & 3) + 8 * (r >> 2) + 4 * hi; }
__device__ __forceinline__ int toff(int row, int ch) { return 256 * row + 16 * (ch ^ (((row & 3) << 2) | ((row >> 2) & 3))); }
__device__ __forceinline__ void stage_tile(RLAS char* T, const bf16_t* __restrict__ g, int tid) {
    u32x4 v[4];
#pragma unroll
    for (int i = 0; i < 4; ++i) { const int idx = tid + 512 * i, row = idx >> 4, ch = idx & 15; v[i] = *(const u32x4*)(g + (size_t)row * 512 + ch * 8); }
#pragma unroll
    for (int i = 0; i < 4; ++i) { const int idx = tid + 512 * i, row = idx >> 4, ch = idx & 15; *(RLAS u32x4*)(T + toff(row, ch)) = v[i]; }
}
__device__ __forceinline__ bf16x8 rowfrag(const RLAS char* T, int row, int ch) { return *(const RLAS bf16x8*)(T + toff(row, ch)); }
__device__ __forceinline__ s16x4 trd(const RLAS char* p) { return __builtin_bit_cast(s16x4, __builtin_amdgcn_ds_read_tr16_b64_v4i16((RLAS v4i16_t*)p)); }
__device__ __forceinline__ bf16x8 trfrag(const RLAS char* T, int rbase, int cbase, int lane) {
    const int g = lane >> 4, ii = lane & 15, q = ii >> 2, p = ii & 3, row = rbase + 8 * (g >> 1) + q, chunk = ((cbase + 16 * (g & 1)) >> 3) + (p >> 1);
    const s16x4 lo = trd(T + toff(row, chunk) + 8 * (p & 1)), hi = trd(T + toff(row + 4, chunk) + 8 * (p & 1));
    return (bf16x8){lo[0], lo[1], lo[2], lo[3], hi[0], hi[1], hi[2], hi[3]};
}
__device__ __forceinline__ void s_update(f32x16 (&S)[2], const RLAS char* Tk, const RLAS char* Tv, float cdec, int wa, int wb, int lane) {
#pragma unroll
    for (int n = 0; n < 2; ++n)
#pragma unroll
        for (int r = 0; r < 16; ++r) S[n][r] *= cdec;
#pragma unroll 2
    for (int ks = 0; ks < 8; ++ks) { const bf16x8 a = trfrag(Tk, 16 * ks, 32 * wa, lane);
#pragma unroll
        for (int n = 0; n < 2; ++n) { const bf16x8 b = trfrag(Tv, 16 * ks, 64 * wb + 32 * n, lane); S[n] = __builtin_amdgcn_mfma_f32_32x32x16_bf16(a, b, S[n], 0, 0, 0); } }
}
__device__ __forceinline__ int chunk_row(int b, int c) { return c < 0 ? MLAT + b * CTXL + (c + 2) * 128 : b * SEQ + c * 128; }
__device__ __forceinline__ int slot_chunk(int slot, int d, int k) {
    if (slot == 0) return d == 0 ? -2 + k : -1 - k;
    const int p = slot - 1, sg = d == 0 ? p : NSEG - 1 - p; return d == 0 ? sg * SEGC + k : sg * SEGC + (SEGC - 1 - k);
}
__device__ __forceinline__ void r1_unit(int b, int h, int d, int slot, const bf16_t* __restrict__ RKD, const bf16_t* __restrict__ RV, const float* __restrict__ decay_logit, float* __restrict__ E, RLAS char* lds, int wid) {
    const int lane = lane_now(), tid = wid * 64 + lane, wa = wid >> 1, wb = wid & 1;
    const float cdec = __builtin_amdgcn_exp2f(128.f * log_sigmoid(decay_logit[d * 4 + h]) * 1.4426950408889634f);
    f32x16 S[2] = {};
    const int nch = slot == 0 ? 2 : SEGC;
    for (int k = 0; k < nch; ++k) {
        const int m0 = chunk_row(b, slot_chunk(slot, d, k));
        __syncthreads();
        stage_tile(lds + T_K, RKD + (size_t)d * MTOT * 512 + (size_t)m0 * 512 + h * 128, tid);
        stage_tile(lds + T_V, RV + (size_t)m0 * 512 + h * 128, tid);
        __syncthreads();
        s_update(S, lds + T_K, lds + T_V, cdec, wa, wb, lane);
    }
    float* e = E + ((size_t)((b * 4 + h) * 2 + d) * NSLOT + slot) * E_UNIT + tid;
#pragma unroll
    for (int n = 0; n < 2; ++n)
#pragma unroll
        for (int r = 0; r < 16; ++r) e[(n * 16 + r) * 512] = S[n][r];
}
__device__ __forceinline__ void r3_unit(int b, int h, int sg, const bf16_t* __restrict__ RQ, const bf16_t* __restrict__ RKD, const bf16_t* __restrict__ RV, const bf16_t* __restrict__ RG,
                                        const float* __restrict__ decay_logit, const float* __restrict__ gn_g, const float* __restrict__ E, float* __restrict__ TMP, bf16_t* __restrict__ YA, RLAS char* lds, int wid) {
    const int lane = lane_now(), tid = wid * 64 + lane, wa = wid >> 1, wb = wid & 1, r32 = lane & 31, hi = lane >> 5;
    RLAS char* Tq = lds + T_Q; RLAS char* Tk = lds + T_K; RLAS char* Tv = lds + T_V; RLAS char* Ts = lds + T_S; RLAS float* stg = (RLAS float*)lds;
#pragma unroll 1
    for (int d = 0; d < 2; ++d) {
        const float l2g = log_sigmoid(decay_logit[d * 4 + h]) * 1.4426950408889634f;
        const float cdec = __builtin_amdgcn_exp2f(128.f * l2g), cseg = __builtin_amdgcn_exp2f(128.f * SEGC * l2g);
        const int p = d == 0 ? sg : NSEG - 1 - sg;
        const float* Eb = E + (size_t)((b * 4 + h) * 2 + d) * NSLOT * E_UNIT + tid;
        f32x16 S[2];
#pragma unroll
        for (int n = 0; n < 2; ++n)
#pragma unroll
            for (int r = 0; r < 16; ++r) S[n][r] = Eb[(n * 16 + r) * 512];
        for (int pp = 0; pp < p; ++pp) { const float* Ep = Eb + (size_t)(1 + pp) * E_UNIT;
#pragma unroll
            for (int n = 0; n < 2; ++n)
#pragma unroll
                for (int r = 0; r < 16; ++r) S[n][r] = S[n][r] * cseg + Ep[(n * 16 + r) * 512]; }
        const f32x2 gng = *(const f32x2*)(gn_g + d * 512 + h * 128 + 2 * lane);
        __syncthreads();
#define WRITE_ST() do { _Pragma("unroll") for (int n = 0; n < 2; ++n) { const int e = 64 * wb + 32 * n + r32; _Pragma("unroll") for (int g4 = 0; g4 < 4; ++g4) { \
            u32x2 w; w.x = pg8::cvt_pk_bf16(S[n][4 * g4], S[n][4 * g4 + 1]); w.y = pg8::cvt_pk_bf16(S[n][4 * g4 + 2], S[n][4 * g4 + 3]); \
            *(RLAS u32x2*)(Ts + toff(e, 4 * wa + g4) + 8 * hi) = w; } } } while (0)
        WRITE_ST();
        for (int k = 0; k < SEGC; ++k) {
            const int c = d == 0 ? sg * SEGC + k : sg * SEGC + (SEGC - 1 - k), m0 = b * SEQ + c * 128;
            __syncthreads();
            stage_tile(Tq, RQ + (size_t)m0 * 512 + h * 128, tid);
            stage_tile(Tk, RKD + (size_t)d * MTOT * 512 + (size_t)m0 * 512 + h * 128, tid);
            stage_tile(Tv, RV + (size_t)m0 * 512 + h * 128, tid);
            __syncthreads();
            f32x16 sc[2] = {};
#pragma unroll 2
            for (int ks = 0; ks < 8; ++ks) { const bf16x8 a = rowfrag(Tk, 32 * wa + r32, 2 * ks + hi);
#pragma unroll
                for (int n = 0; n < 2; ++n) { const bf16x8 bq = rowfrag(Tq, 64 * wb + 32 * n + r32, 2 * ks + hi); sc[n] = __builtin_amdgcn_mfma_f32_32x32x16_bf16(a, bq, sc[n], 0, 0, 0); } }
            s_update(S, Tk, Tv, cdec, wa, wb, lane);
            __syncthreads();
#pragma unroll
            for (int n = 0; n < 2; ++n) { const int i = 64 * wb + 32 * n + r32; const float rf = __builtin_amdgcn_exp2f(l2g * (float)(d == 0 ? i - 127 : -i));
#pragma unroll
                for (int g4 = 0; g4 < 4; ++g4) { float pv[4];
#pragma unroll
                    for (int q = 0; q < 4; ++q) { const int j = 32 * wa + 8 * g4 + 4 * hi + q; const bool keep = d == 0 ? (i >= j) : (j >= i); pv[q] = keep ? sc[n][4 * g4 + q] * rf : 0.f; }
                    u32x2 w; w.x = pg8::cvt_pk_bf16(pv[0], pv[1]); w.y = pg8::cvt_pk_bf16(pv[2], pv[3]);
                    *(RLAS u32x2*)(Tk + toff(i, 4 * wa + g4) + 8 * hi) = w; } }
            __syncthreads();
            f32x16 oP[2] = {};
#pragma unroll 2
            for (int ks = 0; ks < 8; ++ks) { const bf16x8 aq = rowfrag(Tq, 32 * wa + r32, 2 * ks + hi);
#pragma unroll
                for (int n = 0; n < 2; ++n) { const bf16x8 bs = rowfrag(Ts, 64 * wb + 32 * n + r32, 2 * ks + hi); oP[n] = __builtin_amdgcn_mfma_f32_32x32x16_bf16(aq, bs, oP[n], 0, 0, 0); } }
#pragma unroll
            for (int r = 0; r < 16; ++r) { const int i = 32 * wa + crow(r, hi); const float qd = __builtin_amdgcn_exp2f(l2g * (float)(d == 0 ? i + 1 : 128 - i)); oP[0][r] *= qd; oP[1][r] *= qd; }
#pragma unroll 2
            for (int ks = 0; ks < 8; ++ks) { const bf16x8 ap = rowfrag(Tk, 32 * wa + r32, 2 * ks + hi);
#pragma unroll
                for (int n = 0; n < 2; ++n) { const bf16x8 bv = trfrag(Tv, 16 * ks, 64 * wb + 32 * n, lane); oP[n] = __builtin_amdgcn_mfma_f32_32x32x16_bf16(ap, bv, oP[n], 0, 0, 0); } }
            __syncthreads();
#pragma unroll
            for (int n = 0; n < 2; ++n)
#pragma unroll
                for (int r = 0; r < 16; ++r) stg[(32 * wa + crow(r, hi)) * 128 + 64 * wb + 32 * n + r32] = oP[n][r];
            WRITE_ST();
            __syncthreads();
#pragma unroll 4
            for (int rr = 0; rr < 16; ++rr) { const int i = 16 * wid + rr; const size_t m = (size_t)m0 + i;
                const f32x2 v = *(const RLAS f32x2*)(stg + i * 128 + 2 * lane);
                const float s1 = wave_sum(v.x + v.y), s2 = wave_sum(v.x * v.x + v.y * v.y);
                const float mu = s1 * (1.f / 128.f), var = s2 * (1.f / 128.f) - mu * mu, rs = rsqrtf(var + GN_EPS);
                const f32x2 on = (v - mu) * rs * gng;
                float* tp = TMP + m * 512 + h * 128 + 2 * lane;
                if (d == 0) *(f32x2*)tp = on;
                else { const f32x2 t = *(const f32x2*)tp; const unsigned rgw = *(const unsigned*)(RG + m * 512 + h * 128 + 2 * lane);
                    const float y0 = __uint_as_float(rgw << 16) * (t.x + on.x), y1 = __uint_as_float(rgw & 0xffff0000u) * (t.y + on.y);
                    *(unsigned*)(YA + m * 1024 + h * 128 + 2 * lane) = pg8::cvt_pk_bf16(y0, y1); } }
        }
        asm volatile("s_waitcnt vmcnt(0)" ::: "memory");
        __syncthreads();
#undef WRITE_ST
    }
}
#undef RLAS
}
#include <hip/hip_cooperative_groups.h>
namespace cg = cooperative_groups;
namespace mk {
#define LAS __attribute__((address_space(3)))
using pg8::Unit; using pg8::Gemm; using pg8::StaticOrder; using pg8::cvt_pk_bf16;
constexpr int NTHR = 512, NWAVES = 8, LDS_BYTES = 147456;
constexpr float LOG2E = 1.4426950408889634f;

struct Args { const float* in[19]; float* out; unsigned char* ws; int ph_lo, ph_hi; };

__device__ __forceinline__ void store8(bf16_t* p, f32x4 a, f32x4 b) {
    u32x4 w; w.x = cvt_pk_bf16(a[0], a[1]); w.y = cvt_pk_bf16(a[2], a[3]); w.z = cvt_pk_bf16(b[0], b[1]); w.w = cvt_pk_bf16(b[2], b[3]); *(u32x4*)p = w;
}
__device__ __forceinline__ f32x4 silu4(f32x4 v) { f32x4 r; r.x = siluf(v.x); r.y = siluf(v.y); r.z = siluf(v.z); r.w = siluf(v.w); return r; }

__device__ __forceinline__ int colmap_in(int np) {
    const int pn = np >> 8, tl = np & 255, bj = tl >> 7, u = tl & 127, g = pn >> 1, sub = pn & 1;
    if (g == 0 || g == 1) return 512 * g + 256 * sub + 128 * (u >> 6) + 64 * bj + (u & 63);
    if (g == 4 || g == 5) return 512 * g + 256 * sub + 64 * (u >> 5) + 32 * bj + (u & 31);
    return np;
}
__device__ __forceinline__ int colmap_up(int np) { const int pn = np >> 8, tl = np & 255, bj = tl >> 7, u = tl & 127; return bj * DFF + 128 * pn + u; }

__device__ __forceinline__ unsigned pk2(float lo, float hi) { return (unsigned)f2bf(lo) | ((unsigned)f2bf(hi) << 16); }
__device__ __forceinline__ void transpose_item(const float* __restrict__ W, int K, int N, bf16_t* __restrict__ WT, int k0, int nrow0, int src0, LAS float* scr, int lane) {
#pragma unroll 8
    for (int i = 0; i < 32; ++i) { const int kk = 2 * i + (lane >> 5); scr[kk * 33 + (lane & 31)] = W[(size_t)(k0 + kk) * N + src0 + (lane & 31)]; }
    asm volatile("s_waitcnt lgkmcnt(0)" ::: "memory");
    const int c = lane & 7;
#pragma unroll
    for (int j = 0; j < 4; ++j) { const int n = (lane >> 3) + 8 * j; const LAS float* s = scr + (8 * c) * 33 + n;
        u32x4 o; o.x = pk2(s[0 * 33], s[1 * 33]); o.y = pk2(s[2 * 33], s[3 * 33]); o.z = pk2(s[4 * 33], s[5 * 33]); o.w = pk2(s[6 * 33], s[7 * 33]);
        *(u32x4*)(WT + (size_t)(nrow0 + n) * K + k0 + 8 * c) = o; }
    asm volatile("s_waitcnt lgkmcnt(0)" ::: "memory");
}

struct EpiWin {
    static constexpr bool PERM = true, AFTER_DRAIN = false;
    bf16_t *RQ, *RKD, *RV, *RG, *DQ, *DK, *DV; const float *cosr, *sinr, *cosd, *sind, *decay_logit;
    __device__ __forceinline__ void operator()(const f32x4 (&acc)[2][2][4][2], const Unit& u, int wr, int wc, int fr, int fq) const {
        const int g = u.pn >> 1, sub = u.pn & 1; const bool lat = u.pm < MLAT / 256;
        const int row0 = u.pm * 256 + wr * 64 + fr, ub = 32 * wc + 8 * fq;
        if (!lat && (g == 0 || g == 3 || g == 4)) return;
        if (g == 0 || g == 1 || g == 4 || g == 5) {
            const bool ret = g < 2;
            const int col1 = ret ? 256 * sub + 128 * (wc >> 1) + (ub & 63) : 256 * sub + 64 * wc + 8 * fq;
            const int col2 = col1 + (ret ? 64 : 32);
            const float* ct = ret ? cosr + (ub & 63) : cosd + 8 * fq; const float* st = ret ? sinr + (ub & 63) : sind + 8 * fq; const int tstr = ret ? 64 : 32;
            float l2g0 = 0.f, l2g1 = 0.f;
            if (g == 1) { const int h = 2 * sub + (wc >> 1); l2g0 = log_sigmoid(decay_logit[h]) * LOG2E; l2g1 = log_sigmoid(decay_logit[4 + h]) * LOG2E; }
#pragma unroll
            for (int ai = 0; ai < 2; ++ai)
#pragma unroll
                for (int m = 0; m < 4; ++m) {
                    const int row = row0 + 128 * ai + 16 * m;
                    const f32x4 x1a = acc[ai][0][m][0], x1b = acc[ai][0][m][1], x2a = acc[ai][1][m][0], x2b = acc[ai][1][m][1];
                    f32x4 o1a = x1a, o1b = x1b, o2a = x2a, o2b = x2b;
                    if (lat) { const int t = row & 4095; const f32x4 ca = *(const f32x4*)(ct + t * tstr), cb = *(const f32x4*)(ct + t * tstr + 4), sa = *(const f32x4*)(st + t * tstr), sb = *(const f32x4*)(st + t * tstr + 4);
                        o1a = x1a * ca - x2a * sa; o1b = x1b * cb - x2b * sb; o2a = x1a * sa + x2a * ca; o2b = x1b * sb + x2b * cb; }
                    if (g == 0) { store8(RQ + (size_t)row * 512 + col1, o1a, o1b); store8(RQ + (size_t)row * 512 + col2, o2a, o2b); }
                    else if (g == 1) { const int tc = row & 127; const float d0 = __builtin_amdgcn_exp2f(l2g0 * (float)(127 - tc)) * RKSCALE, d1 = __builtin_amdgcn_exp2f(l2g1 * (float)tc) * RKSCALE;
                        bf16_t* p0 = RKD + (size_t)row * 512; bf16_t* p1 = p0 + (size_t)MTOT * 512;
                        store8(p0 + col1, o1a * d0, o1b * d0); store8(p0 + col2, o2a * d0, o2b * d0); store8(p1 + col1, o1a * d1, o1b * d1); store8(p1 + col2, o2a * d1, o2b * d1); }
                    else if (g == 4) { store8(DQ + (size_t)row * 512 + col1, o1a * QSCALE, o1b * QSCALE); store8(DQ + (size_t)row * 512 + col2, o2a * QSCALE, o2b * QSCALE); }
                    else { const size_t kvrow = lat ? (size_t)(row >> 12) * KVL + 256 + (row & 4095) : (size_t)(u.pm - MLAT / 256) * KVL + (row & 255);
                        store8(DK + kvrow * 512 + col1, o1a, o1b); store8(DK + kvrow * 512 + col2, o2a, o2b); }
                }
        } else {
            const int col1 = 256 * sub + ub, col2 = col1 + 128;
#pragma unroll
            for (int ai = 0; ai < 2; ++ai)
#pragma unroll
                for (int m = 0; m < 4; ++m) {
                    const int row = row0 + 128 * ai + 16 * m;
                    if (g == 2) { store8(RV + (size_t)row * 512 + col1, acc[ai][0][m][0], acc[ai][0][m][1]); store8(RV + (size_t)row * 512 + col2, acc[ai][1][m][0], acc[ai][1][m][1]); }
                    else if (g == 3) { store8(RG + (size_t)row * 512 + col1, silu4(acc[ai][0][m][0]), silu4(acc[ai][0][m][1])); store8(RG + (size_t)row * 512 + col2, silu4(acc[ai][1][m][0]), silu4(acc[ai][1][m][1])); }
                    else { const size_t kvrow = lat ? (size_t)(row >> 12) * KVL + 256 + (row & 4095) : (size_t)(u.pm - MLAT / 256) * KVL + (row & 255);
                        store8(DV + kvrow * 512 + col1, acc[ai][0][m][0], acc[ai][0][m][1]); store8(DV + kvrow * 512 + col2, acc[ai][1][m][0], acc[ai][1][m][1]); }
                }
        }
    }
};


struct EpiWout {
    static constexpr bool PERM = false, AFTER_DRAIN = false;
    const float* x; const float* MOD; const float* GAM2; float* OUT; bf16_t* A2; float* rowss;
    __device__ __forceinline__ void operator()(const f32x4 (&acc)[2][2][4][2], const Unit& u, int wr, int wc, int fr, int fq) const {
        const int b = u.pm >> 4, col0 = u.pn * 256 + wc * 32 + 4 * fq, row0 = u.pm * 256 + wr * 64 + fr;
        f32x4 g1v[2][2], gm[2][2];
#pragma unroll
        for (int bj = 0; bj < 2; ++bj)
#pragma unroll
            for (int n = 0; n < 2; ++n) { g1v[bj][n] = *(const f32x4*)(MOD + b * NMOD + 2 * D + col0 + bj * 128 + n * 16); gm[bj][n] = *(const f32x4*)(GAM2 + b * D + col0 + bj * 128 + n * 16); }
#pragma unroll
        for (int ai = 0; ai < 2; ++ai)
#pragma unroll
            for (int m = 0; m < 4; ++m) { const int row = row0 + ai * 128 + m * 16; const size_t off = (size_t)row * D + col0; float s = 0.f;
#pragma unroll
                for (int bj = 0; bj < 2; ++bj)
#pragma unroll
                    for (int n = 0; n < 2; ++n) { const f32x4 xv = *(const f32x4*)(x + off + bj * 128 + n * 16); const f32x4 x1 = xv + g1v[bj][n] * acc[ai][bj][m][n];
                        *(f32x4*)(OUT + off + bj * 128 + n * 16) = x1; s += x1.x * x1.x + x1.y * x1.y + x1.z * x1.z + x1.w * x1.w; const f32x4 hq = x1 * gm[bj][n];
                        u32x2 w; w.x = cvt_pk_bf16(hq.x, hq.y); w.y = cvt_pk_bf16(hq.z, hq.w); *(u32x2*)(A2 + off + bj * 128 + n * 16) = w; }
                s += __shfl_xor(s, 16); s += __shfl_xor(s, 32);
                if (fq == 0) atomicAdd(rowss + row, s); }
    }
};
struct EpiUp {
    static constexpr bool PERM = true, AFTER_DRAIN = false;
    const float* rowss; const float* BIAS2; bf16_t* UH; int row_base;
    __device__ __forceinline__ void operator()(const f32x4 (&acc)[2][2][4][2], const Unit& u, int wr, int wc, int fr, int fq) const {
        const int b = (row_base + u.pm * 256) >> 12, ub = 32 * wc + 8 * fq, row0 = u.pm * 256 + wr * 64 + fr;
        f32x4 bv[2][2];
#pragma unroll
        for (int bj = 0; bj < 2; ++bj)
#pragma unroll
            for (int n = 0; n < 2; ++n) bv[bj][n] = *(const f32x4*)(BIAS2 + b * DFF2 + bj * DFF + 128 * u.pn + ub + 4 * n);
#pragma unroll
        for (int ai = 0; ai < 2; ++ai)
#pragma unroll
            for (int m = 0; m < 4; ++m) { const int row = row0 + ai * 128 + m * 16; const float rstd = rsqrtf(rowss[row_base + row] * (1.f / D) + EPS);
#pragma unroll
                for (int bj = 0; bj < 2; ++bj) store8(UH + (size_t)row * DFF2 + bj * DFF + 128 * u.pn + ub, acc[ai][bj][m][0] * rstd + bv[bj][0], acc[ai][bj][m][1] * rstd + bv[bj][1]); }
    }
};
struct EpiDown {
    static constexpr bool PERM = false, AFTER_DRAIN = false;
    const float* MOD; float* OUT;
    __device__ __forceinline__ void operator()(const f32x4 (&acc)[2][2][4][2], const Unit& u, int wr, int wc, int fr, int fq) const {
        const int b = u.pm >> 4, col0 = u.pn * 256 + wc * 32 + 4 * fq, row0 = u.pm * 256 + wr * 64 + fr;
        f32x4 g2v[2][2];
#pragma unroll
        for (int bj = 0; bj < 2; ++bj)
#pragma unroll
            for (int n = 0; n < 2; ++n) g2v[bj][n] = *(const f32x4*)(MOD + b * NMOD + 5 * D + col0 + bj * 128 + n * 16);
#pragma unroll
        for (int ai = 0; ai < 2; ++ai)
#pragma unroll
            for (int m = 0; m < 4; ++m) { const size_t off = (size_t)(row0 + ai * 128 + m * 16) * D + col0;
#pragma unroll
                for (int bj = 0; bj < 2; ++bj)
#pragma unroll
                    for (int n = 0; n < 2; ++n) { float* p = OUT + off + bj * 128 + n * 16; *(f32x4*)p = *(const f32x4*)p + g2v[bj][n] * acc[ai][bj][m][n]; } }
    }
};
__device__ __forceinline__ void cvt8(u32x4 w, float (&f)[8]) {
    f[0] = __uint_as_float(w.x << 16); f[1] = __uint_as_float(w.x & 0xffff0000u); f[2] = __uint_as_float(w.y << 16); f[3] = __uint_as_float(w.y & 0xffff0000u);
    f[4] = __uint_as_float(w.z << 16); f[5] = __uint_as_float(w.z & 0xffff0000u); f[6] = __uint_as_float(w.w << 16); f[7] = __uint_as_float(w.w & 0xffff0000u);
}


__device__ __forceinline__ void conv_phase(const bf16_t* __restrict__ UH, bf16_t* __restrict__ Gm, const float* __restrict__ conv_w, const float* __restrict__ conv_b, int row_base, int gt, int T) {
    const int groups = T / 352, rpg = (16384 + groups - 1) / groups;
    if (gt >= groups * 352) return;
    const int grp = gt / 352, jc = gt % 352, j0 = 8 * jc;
    float w0a[8], w1a[8], w2a[8], cba[8], w0b[8], w1b[8], w2b[8], cbb[8];
#pragma unroll
    for (int i = 0; i < 8; ++i) { w0a[i] = conv_w[j0 + i]; w0b[i] = conv_w[DFF + j0 + i]; w1a[i] = conv_w[DFF2 + j0 + i]; w1b[i] = conv_w[DFF2 + DFF + j0 + i];
        w2a[i] = conv_w[2 * DFF2 + j0 + i]; w2b[i] = conv_w[2 * DFF2 + DFF + j0 + i]; cba[i] = conv_b[j0 + i]; cbb[i] = conv_b[DFF + j0 + i]; }
    const int r0 = grp * rpg, r1 = (r0 + rpg < 16384) ? r0 + rpg : 16384;
    if (r0 >= r1) return;
    float pa[8], pb[8], ca[8], cb[8], na[8], nb[8];
    { const int t = (row_base + r0) & 4095;
      if (t > 0) { cvt8(*(const u32x4*)(UH + (size_t)(r0 - 1) * DFF2 + j0), pa); cvt8(*(const u32x4*)(UH + (size_t)(r0 - 1) * DFF2 + DFF + j0), pb); }
      else {
#pragma unroll
          for (int i = 0; i < 8; ++i) { pa[i] = 0.f; pb[i] = 0.f; } }
      cvt8(*(const u32x4*)(UH + (size_t)r0 * DFF2 + j0), ca); cvt8(*(const u32x4*)(UH + (size_t)r0 * DFF2 + DFF + j0), cb); }
    for (int r = r0; r < r1; ++r) {
        const int t = (row_base + r) & 4095;
        if (r + 1 < 16384) { cvt8(*(const u32x4*)(UH + (size_t)(r + 1) * DFF2 + j0), na); cvt8(*(const u32x4*)(UH + (size_t)(r + 1) * DFF2 + DFF + j0), nb); }
        else {
#pragma unroll
            for (int i = 0; i < 8; ++i) { na[i] = 0.f; nb[i] = 0.f; } }
        float o[8];
#pragma unroll
        for (int i = 0; i < 8; ++i) { const float pva = t > 0 ? pa[i] : 0.f, pvb = t > 0 ? pb[i] : 0.f, nva = t < 4095 ? na[i] : 0.f, nvb = t < 4095 ? nb[i] : 0.f;
            const float a = cba[i] + w0a[i] * pva + w1a[i] * ca[i] + w2a[i] * nva, bq = cbb[i] + w0b[i] * pvb + w1b[i] * cb[i] + w2b[i] * nvb; o[i] = siluf(a) * bq; }
        u32x4 w; w.x = cvt_pk_bf16(o[0], o[1]); w.y = cvt_pk_bf16(o[2], o[3]); w.z = cvt_pk_bf16(o[4], o[5]); w.w = cvt_pk_bf16(o[6], o[7]);
        *(u32x4*)(Gm + (size_t)(row_base + r) * DFF + j0) = w;
#pragma unroll
        for (int i = 0; i < 8; ++i) { pa[i] = ca[i]; pb[i] = cb[i]; ca[i] = na[i]; cb[i] = nb[i]; }
    }
}


#define XB_TMO      128
#define XB_XCNT(j)  (256  + 64 * (j))
#define XB_XSUB(j)  (1280 + 64 * (j))
#define XB_XGEN(j)  (2304 + 64 * (j))
#define XB_TOP      3328
#define XB_TOPGEN   3392
#define XCD_BAR_WORDS 3456
#define XB_SPIN_CAP (1u << 18)
__device__ __forceinline__ unsigned xb_ld(unsigned* p)              { return __hip_atomic_load(p, __ATOMIC_RELAXED, __HIP_MEMORY_SCOPE_AGENT); }
__device__ __forceinline__ unsigned xb_add(unsigned* p, unsigned v) { return __hip_atomic_fetch_add(p, v, __ATOMIC_RELAXED, __HIP_MEMORY_SCOPE_AGENT); }
__device__ __forceinline__ unsigned xb_xcc_id() { return (unsigned)__builtin_amdgcn_s_getreg((3 << 11) | 20) & 0xFu; }
#define XB_SPIN(cond, bar) do { unsigned _sp = 0; while (cond) { __builtin_amdgcn_s_sleep(1); \
    if ((++_sp & 255u) == 0u) { if (xb_ld(&(bar)[XB_TMO])) break; if (_sp > XB_SPIN_CAP) { atomicAdd(&(bar)[XB_TMO], 1u); break; } } } } while (0)
struct XcdBarrier { unsigned* bar; unsigned x; volatile LAS unsigned* st; };
__device__ __forceinline__ void xcd_barrier_complete(unsigned* bar, unsigned x, unsigned G, unsigned& nloc, unsigned& nx) {
    unsigned sum, cnt, mine, sp = 0u;
    for (;;) {
        sum = 0u; cnt = 0u; mine = 0u;
#pragma unroll
        for (unsigned j = 0; j < 16; ++j) { const unsigned c = xb_ld(&bar[XB_XCNT(j)]); sum += c; cnt += (c > 0u) ? 1u : 0u; mine = (j == x) ? c : mine; }
        if (sum == G) break;
        __builtin_amdgcn_s_sleep(1);
        if ((++sp & 255u) == 0u) { if (xb_ld(&bar[XB_TMO])) break; if (sp > XB_SPIN_CAP) { atomicAdd(&bar[XB_TMO], 1u); break; } }
    }
    nloc = mine > 0u ? mine : 1u; nx = cnt > 0u ? cnt : 1u;
}
__device__ __forceinline__ void xcd_barrier(const XcdBarrier& b, int wave, unsigned G) {
    asm volatile("s_waitcnt vmcnt(0)" ::: "memory");
    __syncthreads();
    if (wave == 0) { if (lane_now() == 0) {
        unsigned* bar = b.bar;
        __builtin_amdgcn_s_waitcnt(0);
        unsigned nloc = b.st[0], nx = b.st[1];
        if (nloc == 0u) { xcd_barrier_complete(bar, b.x, G, nloc, nx); b.st[0] = nloc; b.st[1] = nx; }
        const unsigned old = xb_add(&bar[XB_XSUB(b.x)], 1u);
        const unsigned gen = old / nloc;
        if (old + 1u == (gen + 1u) * nloc) {
            __builtin_amdgcn_fence(__ATOMIC_RELEASE, "agent");
            asm volatile("s_waitcnt vmcnt(0)" ::: "memory");
            const unsigned og = xb_add(&bar[XB_TOP], 1u);
            const unsigned tg = og / nx;
            if (og + 1u == (tg + 1u) * nx) xb_add(&bar[XB_TOPGEN], 1u);
            else XB_SPIN(xb_ld(&bar[XB_TOPGEN]) == tg, bar);
            __builtin_amdgcn_fence(__ATOMIC_ACQUIRE, "agent");
            xb_add(&bar[XB_XGEN(b.x)], 1u);
            asm volatile("s_waitcnt vmcnt(0)" ::: "memory");
        } else {
            XB_SPIN(xb_ld(&bar[XB_XGEN(b.x)]) == gen, bar);
            __builtin_amdgcn_fence(__ATOMIC_ACQUIRE, "agent");
            asm volatile("s_waitcnt vmcnt(0)" ::: "memory");
        }
    } }
    __syncthreads();
}

__global__ void __launch_bounds__(NTHR, 2) mk_fwd(Args args) {
    __builtin_assume(threadIdx.y == 0); __builtin_assume(threadIdx.z == 0);
    extern __shared__ __attribute__((aligned(16))) unsigned char lds_raw[];
    LAS unsigned char* lds = (LAS unsigned char*)lds_raw;
    cg::grid_group grid = cg::this_grid();
    const int wave = __builtin_amdgcn_readfirstlane(threadIdx.x >> 6), wg = blockIdx.x, G = gridDim.x;
#define lane lane_now()
#define tid (wave * 64 + lane_now())
    unsigned char* ws = args.ws;
    const float* x = args.in[0]; const float* c = args.in[1]; const float* ctx = args.in[2]; const float* c_ctx = args.in[3];
    const float* w_mod = args.in[4]; const float* b_mod = args.in[5]; const float* norm1_g = args.in[6]; const float* w_in = args.in[7];
    const float* decay_logit = args.in[8]; const float* diff_lambda = args.in[10];
    const float* w_out = args.in[12]; const float* norm2_g = args.in[13]; const float* w_up = args.in[14]; const float* w_down = args.in[17];
    float* MOD = (float*)(ws + WS_MOD); float* GAM2 = (float*)(ws + WS_GAM2); float* BIAS2 = (float*)(ws + WS_BIAS2); float* MISC = (float*)(ws + WS_MISC);
    float* cosr = (float*)(ws + WS_COSR); float* sinr = (float*)(ws + WS_SINR); float* cosd = (float*)(ws + WS_COSD); float* sind = (float*)(ws + WS_SIND);
    bf16_t* WinT = (bf16_t*)(ws + WS_WIN); bf16_t* WoutT = (bf16_t*)(ws + WS_WOUT); bf16_t* WupT = (bf16_t*)(ws + WS_WUP); bf16_t* WdownT = (bf16_t*)(ws + WS_WDOWN);
    bf16_t* XN = (bf16_t*)(ws + WS_XN); bf16_t* YA = (bf16_t*)(ws + WS_YA); bf16_t* A2 = (bf16_t*)(ws + WS_A2); bf16_t* UH = (bf16_t*)(ws + WS_UH); bf16_t* Gb = (bf16_t*)(ws + WS_G); float* rowss = (float*)(ws + WS_ROWSS);
    const float* gn_g = args.in[9]; const float* subln_g = args.in[11]; const float* conv_w = args.in[15]; const float* conv_b = args.in[16]; const float* final_g = args.in[18];
    const int lo = args.ph_lo, hi = args.ph_hi;
    XcdBarrier xb; xb.bar = (unsigned*)(ws + WS_XBAR); xb.x = xb_xcc_id(); xb.st = (volatile LAS unsigned*)(lds + LDS_BYTES - 16);
    if (threadIdx.x < 4) ((LAS unsigned*)(lds + LDS_BYTES - 16))[threadIdx.x] = 0u;
    __syncthreads();
    if (threadIdx.x == 0) (void)xb_add(&xb.bar[XB_XCNT(xb.x)], 1u);
#define IN(k) (lo <= (k) && (k) < hi)
#ifndef PROBE_MASK
#define PROBE_MASK 0
#endif
#define NREP(k) (((PROBE_MASK >> (k)) & 1) ? 2 : 1)
#define SEAM(k) do { if (IN(k) && IN((k) + 1)) { if ((k) == 0) grid.sync(); else xcd_barrier(xb, wave, (unsigned)G); } } while (0)

    if (IN(0)) for (int rep_ = 0; rep_ < NREP(0); ++rep_) { if (rep_) xcd_barrier(xb, wave, (unsigned)G);
        LAS float* sc = (LAS float*)lds; LAS float* red = sc + 9 * 1024;
        for (int i = tid; i < 9 * 1024; i += NTHR) { const int r = i >> 10, k = i & 1023; sc[i] = siluf(r < 8 ? c[r * D + k] : c_ctx[k]); }
        __syncthreads();
        for (int cw = wg; cw < 256; cw += G) {
            const int ks = tid / 24, col = tid % 24;
            if (tid < 504) {
                float a[9];
#pragma unroll
                for (int r = 0; r < 9; ++r) a[r] = 0.f;
                for (int k = ks; k < D; k += 21) { const float w = w_mod[(size_t)k * NMOD + 24 * cw + col];
#pragma unroll
                    for (int r = 0; r < 9; ++r) a[r] += sc[r * 1024 + k] * w; }
#pragma unroll
                for (int r = 0; r < 9; ++r) red[(ks * 24 + col) * 9 + r] = a[r];
            }
            __syncthreads();
            if (tid < 216) { const int cc = tid / 9, r = tid % 9; float s = 0.f; for (int q = 0; q < 21; ++q) s += red[(q * 24 + cc) * 9 + r]; MOD[r * NMOD + 24 * cw + cc] = s + b_mod[24 * cw + cc]; }
            __syncthreads();
        }
        {
            LAS float* scr = (LAS float*)(lds + wave * 8448);
            constexpr int I_IN = 16 * (INC / 32), I_OUT = 16 * (D / 32), I_UP = 16 * (DFF2 / 32), I_DN = (DFF / 64) * (D / 32), NIT = I_IN + I_OUT + I_UP + I_DN;
            for (int it = wg * NWAVES + wave; it < NIT; it += G * NWAVES) {
                int r = it;
                if (r < I_IN) { const int nb = r % (INC / 32), kb = r / (INC / 32); transpose_item(w_in, D, INC, WinT, 64 * kb, 32 * nb, colmap_in(32 * nb), scr, lane); continue; } r -= I_IN;
                if (r < I_OUT) { const int nb = r % (D / 32), kb = r / (D / 32); transpose_item(w_out, D, D, WoutT, 64 * kb, 32 * nb, 32 * nb, scr, lane); continue; } r -= I_OUT;
                if (r < I_UP) { const int nb = r % (DFF2 / 32), kb = r / (DFF2 / 32); transpose_item(w_up, D, DFF2, WupT, 64 * kb, 32 * nb, colmap_up(32 * nb), scr, lane); continue; } r -= I_UP;
                { const int nb = r % (D / 32), kb = r / (D / 32); transpose_item(w_down, DFF, D, WdownT, 64 * kb, 32 * nb, 32 * nb, scr, lane); }
            }
        }
        for (int idx = wg * NTHR + tid; idx < SEQ * 96; idx += G * NTHR) {
            if (idx < SEQ * 64) { const int pos = idx >> 6, j = idx & 63; const float inv = powf(10000.f, -(float)(j & 31) / 32.f); const float p = (j < 32) ? (float)(pos >> 6) : (float)(pos & 63); const float a = p * inv; cosr[idx] = cosf(a); sinr[idx] = sinf(a); }
            else { const int i2 = idx - SEQ * 64, pos = i2 >> 5, j = i2 & 31; const float inv = powf(10000.f, -(float)(j & 15) / 16.f); const float p = (j < 16) ? (float)(pos >> 6) : (float)(pos & 63); const float a = p * inv; cosd[i2] = cosf(a); sind[i2] = sinf(a); }
        }
        if (wg == 0 && tid == 0) { float a = 0.f, bb = 0.f; for (int i = 0; i < 64; ++i) { a += diff_lambda[i] * diff_lambda[64 + i]; bb += diff_lambda[128 + i] * diff_lambda[192 + i]; } MISC[0] = expf(a) - expf(bb) + LAMBDA_INIT; }
        __syncthreads();
    }
    SEAM(0);
#ifdef PROBE_SYNCS
    for (int i_ = 0; i_ < PROBE_SYNCS; ++i_) grid.sync();
#endif
    if (IN(1)) for (int rep_ = 0; rep_ < NREP(1); ++rep_) { if (rep_) xcd_barrier(xb, wave, (unsigned)G);
        const int nwv = G * NWAVES, gw = wg * NWAVES + wave, rpw = (MTOT + nwv - 1) / nwv;
        int curb = -1; f32x4 gam[4], shv[4];
        for (int m = gw * rpw; m < (gw + 1) * rpw && m < MTOT; ++m) {
            const int r = m < MLAT ? (m >> 12) : 8;
            if (r != curb) { curb = r; const float* sh = MOD + r * NMOD; const float* scp = sh + D;
#pragma unroll
                for (int j = 0; j < 4; ++j) { const int k = 4 * lane + 256 * j; gam[j] = *(const f32x4*)(norm1_g + k) * (1.f + *(const f32x4*)(scp + k)); shv[j] = *(const f32x4*)(sh + k); } }
            const float* xr = m < MLAT ? x + (size_t)m * D : ctx + (size_t)(m - MLAT) * D;
            f32x4 v[4]; float s = 0.f;
#pragma unroll
            for (int j = 0; j < 4; ++j) { v[j] = *(const f32x4*)(xr + 4 * lane + 256 * j); s += v[j].x * v[j].x + v[j].y * v[j].y + v[j].z * v[j].z + v[j].w * v[j].w; }
            const float rstd = rsqrtf(wave_sum(s) * (1.f / D) + EPS);
#pragma unroll
            for (int j = 0; j < 4; ++j) { const f32x4 h = v[j] * rstd * gam[j] + shv[j]; u32x2 w; w.x = cvt_pk_bf16(h.x, h.y); w.y = cvt_pk_bf16(h.z, h.w); *(u32x2*)(XN + (size_t)m * D + 4 * lane + 256 * j) = w; }
        }
        const int gt = wg * NTHR + tid;
        if (gt < NB * D) { const int b = gt / D, k = gt % D; GAM2[gt] = norm2_g[k] * (1.f + MOD[b * NMOD + 4 * D + k]); }
        else if (gt < NB * D + DFF2) { const int n = gt - NB * D; float a[8];
#pragma unroll
            for (int b = 0; b < 8; ++b) a[b] = 0.f;
            for (int k = 0; k < D; ++k) { const float w = w_up[(size_t)k * DFF2 + n];
#pragma unroll
                for (int b = 0; b < 8; ++b) a[b] += MOD[b * NMOD + 3 * D + k] * w; }
#pragma unroll
            for (int b = 0; b < 8; ++b) BIAS2[b * DFF2 + n] = a[b]; }
    }
    SEAM(1);
    if (IN(2)) for (int rep_ = 0; rep_ < NREP(2); ++rep_) { if (rep_) xcd_barrier(xb, wave, (unsigned)G);
        Gemm g{XN, WinT, MTOT, INC, D}; StaticOrder S; S.init(MTOT, INC, G, wg);
        EpiWin E{(bf16_t*)(ws + WS_RQ), (bf16_t*)(ws + WS_RKD), (bf16_t*)(ws + WS_RV), (bf16_t*)(ws + WS_RG), (bf16_t*)(ws + WS_DQ), (bf16_t*)(ws + WS_DK), (bf16_t*)(ws + WS_DV), cosr, sinr, cosd, sind, decay_logit};
        pg8::gemm_phase<EpiWin, StaticOrder, true, true>(lds, g, S, E, wave);
    }
    SEAM(2);
    if (IN(3)) for (int rep_ = 0; rep_ < NREP(3); ++rep_) { if (rep_) xcd_barrier(xb, wave, (unsigned)G);
        for (int u = wg; u < 512; u += G) { const int slot = (u + (u >> 8)) & 7, d = (u >> 3) & 1, h = (u >> 4) & 3, b = (u >> 6) & 7;
            rt::r1_unit(b, h, d, slot, (const bf16_t*)(ws + WS_RKD), (const bf16_t*)(ws + WS_RV), decay_logit, (float*)(ws + WS_E), (LAS char*)lds, wave); }
    }
    SEAM(3);
    if (IN(4)) for (int rep_ = 0; rep_ < NREP(4); ++rep_) { if (rep_) xcd_barrier(xb, wave, (unsigned)G);
        const bf16_t* RQ = (const bf16_t*)(ws + WS_RQ); const bf16_t* RKD = (const bf16_t*)(ws + WS_RKD); const bf16_t* RV = (const bf16_t*)(ws + WS_RV); const bf16_t* RG = (const bf16_t*)(ws + WS_RG);
        const bf16_t* DQ = (const bf16_t*)(ws + WS_DQ); const bf16_t* DK = (const bf16_t*)(ws + WS_DK); const bf16_t* DV = (const bf16_t*)(ws + WS_DV);
        float* TMP = (float*)(ws + WS_TMP);
        for (int u = wg; u < 256; u += G)
            rt::r3_unit(u >> 5, (u >> 3) & 3, u & 7, RQ, RKD, RV, RG, decay_logit, gn_g, (const float*)(ws + WS_E), TMP, YA, (LAS char*)lds, wave);
        {
            const float lam = MISC[0];
            const int vcu = (G % 8 == 0) ? (wg % 8) * (G / 8) + wg / 8 : wg;
            for (int u = vcu; u < 1024; u += G) {
                const int h = u >> 8, b = (u & 255) >> 5, qblk = u & 31; const size_t m0 = (size_t)b * SEQ + qblk * 128;
                da::attn_unit(DQ + m0 * 512 + h * 128, DK + (size_t)b * KVL * 512 + h * 128, DV + (size_t)b * KVL * 512 + h * 128, YA + m0 * 1024 + 512 + h * 128, subln_g + h * 128, lam, (char*)lds_raw, wave);
            }
        }
    }
    SEAM(4);
    if (IN(5)) {
        Gemm g{YA, WoutT, MLAT, D, D}; StaticOrder S; S.init(MLAT, D, G, wg);
        EpiWout E{x, MOD, GAM2, args.out, A2, rowss};
        pg8::gemm_phase<EpiWout, StaticOrder, true, true>(lds, g, S, E, wave);
    }
    SEAM(5);
#define UP_HALF(hf) do { \
        if (IN(6 + 2 * (hf))) for (int rep_ = 0; rep_ < NREP(6 + 2 * (hf)); ++rep_) { if (rep_) xcd_barrier(xb, wave, (unsigned)G); \
            Gemm g{A2 + (size_t)(hf) * 16384 * D, WupT, 16384, DFF2, D}; StaticOrder S; S.init(16384, DFF2, G, wg); \
            EpiUp E{rowss, BIAS2, UH, (hf) * 16384}; \
            pg8::gemm_phase<EpiUp, StaticOrder, true, true>(lds, g, S, E, wave); \
        } \
        SEAM(6 + 2 * (hf)); \
        if (IN(7 + 2 * (hf))) for (int rep_ = 0; rep_ < NREP(7 + 2 * (hf)); ++rep_) conv_phase(UH, Gb, conv_w, conv_b, (hf) * 16384, wg * NTHR + tid, G * NTHR); \
        SEAM(7 + 2 * (hf)); } while (0)
    UP_HALF(0);
    UP_HALF(1);
#undef UP_HALF
    if (IN(10)) {
        Gemm g{Gb, WdownT, MLAT, D, DFF}; StaticOrder S; S.init(MLAT, D, G, wg);
        EpiDown E{MOD, args.out};
        pg8::gemm_phase<EpiDown, StaticOrder, true, true>(lds, g, S, E, wave);
    }
    SEAM(10);
    if (IN(11)) {
        const int nwv = G * NWAVES;
        for (int m = wg * NWAVES + wave; m < MLAT; m += nwv) {
            float* xr = args.out + (size_t)m * D; f32x4 v[4]; float s = 0.f;
#pragma unroll
            for (int j = 0; j < 4; ++j) { v[j] = *(const f32x4*)(xr + 4 * lane + 256 * j); s += v[j].x * v[j].x + v[j].y * v[j].y + v[j].z * v[j].z + v[j].w * v[j].w; }
            const float rstd = rsqrtf(wave_sum(s) * (1.f / D) + EPS);
#pragma unroll
            for (int j = 0; j < 4; ++j) *(f32x4*)(xr + 4 * lane + 256 * j) = v[j] * rstd * *(const f32x4*)(final_g + 4 * lane + 256 * j);
        }
    }
#undef IN
#undef SEAM
#undef lane
#undef tid
}
}
#ifndef OPT_LEVEL
#define OPT_LEVEL 2
#endif
static int mk_grid = 0;
static void mk_launch(mk::Args a, int lo, int hi, hipStream_t stream) {
    a.ph_lo = lo; a.ph_hi = hi; void* args[] = {&a};
    hipError_t e = hipLaunchCooperativeKernel((const void*)mk::mk_fwd, dim3(mk_grid), dim3(mk::NTHR), args, mk::LDS_BYTES, stream);
    if (e != hipSuccess) fprintf(stderr, "cooperative launch failed: %s (grid %d)\n", hipGetErrorString(e), mk_grid);
}
extern "C" void kernel_launch(void* const* d_in, const int* in_sizes, int n_in, void* d_out, int out_size, void* d_ws, size_t ws_size, hipStream_t stream) {
    if (ws_size < WS_END || n_in != 19) { fprintf(stderr, "kernel_launch: ws too small %zu or n_in %d\n", ws_size, n_in); return; }
    if (mk_grid == 0) {
        int dev = 0, cus = 0, per_cu = 0; (void)hipGetDevice(&dev); (void)hipDeviceGetAttribute(&cus, hipDeviceAttributeMultiprocessorCount, dev);
        if (hipFuncSetAttribute((const void*)mk::mk_fwd, hipFuncAttributeMaxDynamicSharedMemorySize, mk::LDS_BYTES) != hipSuccess) fprintf(stderr, "hipFuncSetAttribute failed\n");
        if (hipOccupancyMaxActiveBlocksPerMultiprocessor(&per_cu, (const void*)mk::mk_fwd, mk::NTHR, mk::LDS_BYTES) != hipSuccess || per_cu < 1) { fprintf(stderr, "occupancy query: %d\n", per_cu); per_cu = 1; }
        if (per_cu > 1) per_cu = 1;
        mk_grid = cus * per_cu; fprintf(stderr, "mk grid = %d (cus %d)\n", mk_grid, cus);
    }
    const float* x = (const float*)d_in[0]; const float* c = (const float*)d_in[1]; const float* ctx = (const float*)d_in[2]; const float* c_ctx = (const float*)d_in[3];
    const float* w_mod = (const float*)d_in[4]; const float* b_mod = (const float*)d_in[5]; const float* norm1_g = (const float*)d_in[6]; const float* w_in = (const float*)d_in[7];
    const float* decay_logit = (const float*)d_in[8]; const float* gn_g = (const float*)d_in[9]; const float* diff_lambda = (const float*)d_in[10]; const float* subln_g = (const float*)d_in[11];
    const float* w_out = (const float*)d_in[12]; const float* norm2_g = (const float*)d_in[13]; const float* w_up = (const float*)d_in[14]; const float* conv_w = (const float*)d_in[15];
    const float* conv_b = (const float*)d_in[16]; const float* w_down = (const float*)d_in[17]; const float* final_g = (const float*)d_in[18];
    char* ws = (char*)d_ws; float* out = (float*)d_out;
    float* MOD = (float*)(ws + WS_MOD); float* GAM2 = (float*)(ws + WS_GAM2); float* BIAS2 = (float*)(ws + WS_BIAS2); float* MISC = (float*)(ws + WS_MISC); float* rowss = (float*)(ws + WS_ROWSS);
    float* cosr = (float*)(ws + WS_COSR); float* sinr = (float*)(ws + WS_SINR); float* cosd = (float*)(ws + WS_COSD); float* sind = (float*)(ws + WS_SIND);
    bf16_t* XN = (bf16_t*)(ws + WS_XN); float* TMP = (float*)(ws + WS_TMP); bf16_t* A2 = (bf16_t*)(ws + WS_A2);
    bf16_t* YA = (bf16_t*)(ws + WS_YA); bf16_t* G = (bf16_t*)(ws + WS_G); bf16_t* UH = (bf16_t*)(ws + WS_UH);
    nv::P1Out po{(bf16_t*)(ws + WS_RQ), (bf16_t*)(ws + WS_RKD), (bf16_t*)(ws + WS_RV), (bf16_t*)(ws + WS_RG), (bf16_t*)(ws + WS_DQ), (bf16_t*)(ws + WS_DK), (bf16_t*)(ws + WS_DV), cosr, sinr, cosd, sind, decay_logit};
    mk::Args a{}; for (int i = 0; i < 19; ++i) a.in[i] = (const float*)d_in[i]; a.out = out; a.ws = (unsigned char*)d_ws;
    (void)hipMemsetAsync(ws + WS_ZERO, 0, ZERO_BYTES, stream);
#if OPT_LEVEL == 3
    mk_launch(a, 0, 3, stream);
    nv::k_ret<<<32, 128, 0, stream>>>(po.RQ, po.RKD, po.RV, po.RG, decay_logit, gn_g, TMP, YA);
    nv::k_attn<<<dim3(MLAT / 64, 4), 256, 0, stream>>>(po.DQ, po.DK, po.DV, subln_g, MISC, YA);
    mk_launch(a, 5, 12, stream);
    return;
#elif OPT_LEVEL == 2
    mk_launch(a, 0, 12, stream);
    return;
#elif OPT_LEVEL >= 1
    mk_launch(a, 0, 3, stream);
#else
    nv::k_mod<<<(9 * NMOD + 255) / 256, 256, 0, stream>>>(c, c_ctx, w_mod, b_mod, MOD);
    nv::k_small<<<(SEQ * 64 + 255) / 256, 256, 0, stream>>>(MOD, norm2_g, w_up, diff_lambda, GAM2, BIAS2, MISC, cosr, sinr, cosd, sind);
    nv::k_xn<<<MTOT / 4, 256, 0, stream>>>(x, ctx, MOD, norm1_g, XN);
    { float* scr = (float*)(ws + WS_SCR);
    for (int g = 0; g < 7; ++g) {
        nv::k_gemm<<<dim3(512 / 64, MTOT / 64), 256, 0, stream>>>(XN, D, w_in, INC, 512 * g, scr, 512, D);
        nv::k_p1post<<<MTOT, 256, 0, stream>>>(scr, g, po);
    } }
#endif
    nv::k_ret<<<32, 128, 0, stream>>>(po.RQ, po.RKD, po.RV, po.RG, decay_logit, gn_g, TMP, YA);
    nv::k_attn<<<dim3(MLAT / 64, 4), 256, 0, stream>>>(po.DQ, po.DK, po.DV, subln_g, MISC, YA);
    float* scr2 = (float*)(ws + WS_SCR2);
    nv::k_gemm<<<dim3(D / 64, MLAT / 64), 256, 0, stream>>>(YA, D, w_out, D, 0, scr2, D, D);
    nv::k_post_wout<<<MLAT / 4, 256, 0, stream>>>(scr2, x, MOD, GAM2, out, A2, rowss);
    float* scr3 = (float*)(ws + WS_SCR3);
    for (int hf = 0; hf < 2; ++hf) {
        for (int nb = 0; nb < DFF2 / 512; ++nb) {
            nv::k_gemm<<<dim3(512 / 64, 16384 / 64), 256, 0, stream>>>(A2 + (size_t)hf * 16384 * D, D, w_up, DFF2, 512 * nb, scr3, 512, D);
            nv::k_post_up<<<16384, 256, 0, stream>>>(scr3, 512 * nb, hf * 16384, rowss, BIAS2, UH);
        }
        nv::k_conv<<<16384, 256, 0, stream>>>(UH, hf * 16384, conv_w, conv_b, G);
    }
    float* scr4 = (float*)(ws + WS_SCR4);
    nv::k_gemm<<<dim3(D / 64, MLAT / 64), 256, 0, stream>>>(G, DFF, w_down, D, 0, scr4, D, DFF);
    nv::k_post_down<<<MLAT / 4, 256, 0, stream>>>(scr4, MOD, final_g, out);
}
```
